# Optimizing an MI355X kernel written in HIP

```python
import jax, jax.numpy as jnp
from jax import lax
import numpy as np

D_MODEL = 2048
BATCH = 16
SEQ = 256
DEPTH = 2
DEC_BATCH = 2
DEC_SEQ = 4096
PAST_LEN = 512

GRID_W = 64
CHUNK = 64
HEAD_DIM = 128
H_A = 8
H_B = 8
H_C = 8
W_MIX = 8 * HEAD_DIM
CONV_K = 3
D_FF = 4096
N_MOD = 9
ROPE_BASE = 10000.0
EPS = 1e-6

IN_SIZES = [W_MIX, W_MIX, W_MIX, W_MIX, 2 * H_A, 2 * H_A,
            3 * W_MIX, W_MIX, 2 * H_B, 2 * H_B,
            W_MIX, W_MIX, W_MIX, W_MIX,
            3 * D_MODEL]
N_IN = int(sum(IN_SIZES))
IN_OFFSETS = [int(o) for o in np.cumsum(IN_SIZES)[:-1]]

kernel_name = "hybrid_mlstm_deltanet_retention_flow_step"


def rmsnorm(x, g):
    xf = x.astype(jnp.float32)
    y = xf * lax.rsqrt(jnp.mean(xf * xf, axis=-1, keepdims=True) + EPS)
    return (y * g.astype(jnp.float32)).astype(x.dtype)


def head_rms(x, g):
    y = x * lax.rsqrt(jnp.mean(x * x, axis=-1, keepdims=True) + EPS)
    return y * g.astype(jnp.float32)


def l2norm(x):
    return x * lax.rsqrt(jnp.sum(x * x, axis=-1, keepdims=True) + EPS)


def heads(x, h):
    return x.reshape(*x.shape[:-1], h, -1)


def flip(x):
    return jnp.flip(x, axis=1)


def chunk(x):
    b, t, h, d = x.shape
    return x.reshape(b, t // CHUNK, CHUNK, h, d).transpose(1, 0, 3, 2, 4)


def unchunk(y):
    nc, b, h, l, d = y.shape
    return y.transpose(1, 0, 3, 2, 4).reshape(b, nc * l, h, d)


def masks():
    idx = jnp.arange(CHUNK)
    return idx[:, None] >= idx[None, :], idx[:, None] > idx[None, :]


def mlstm_scan(q, k, v, ig, lf, C0, n0, m0):
    qc, kc, vc = chunk(q), chunk(k), chunk(v)
    igc = chunk(ig[..., None])[..., 0]
    b = jnp.cumsum(chunk(lf[..., None])[..., 0], axis=-1)
    incl, _ = masks()
    logD = jnp.where(incl, b[..., :, None] - b[..., None, :] + igc[..., None, :], -jnp.inf)
    m_in = jnp.max(logD, axis=-1)
    bL = b[..., -1]
    log_end = bL[..., None] - b + igc
    m_end = jnp.max(log_end, axis=-1)
    qk = jnp.einsum('nbhld,nbhmd->nbhlm', qc, kc)

    def step(carry, inp):
        C, n, m = carry
        qn, kn, vn, bn, logDn, m_inn, qkn, le_n, me_n, bL_n = inp
        m_i = jnp.maximum(bn + m[..., None], m_inn)
        w_prev = jnp.exp(bn + m[..., None] - m_i)
        S = qkn * jnp.exp(logDn - m_i[..., None])
        num = w_prev[..., None] * jnp.einsum('bhld,bhde->bhle', qn, C) + jnp.einsum('bhlm,bhme->bhle', S, vn)
        den = w_prev * jnp.einsum('bhld,bhd->bhl', qn, n) + jnp.sum(S, axis=-1)
        h = num / jnp.maximum(jnp.abs(den), jnp.exp(-m_i))[..., None]
        m_new = jnp.maximum(bL_n + m, me_n)
        w_s = jnp.exp(bL_n + m - m_new)
        w_t = jnp.exp(le_n - m_new[..., None])
        C = w_s[..., None, None] * C + jnp.einsum('bhld,bhle->bhde', kn * w_t[..., None], vn)
        n = w_s[..., None] * n + jnp.einsum('bhld,bhl->bhd', kn, w_t)
        return (C, n, m_new), h

    (C, n, m), h = lax.scan(step, (C0, n0, m0), (qc, kc, vc, b, logD, m_in, qk, log_end, m_end, bL))
    return unchunk(h), C, n, m


def delta_scan(q, k, v, g, beta, S0):
    qc, kc, vc = chunk(q), chunk(k), chunk(v)
    G = jnp.cumsum(chunk(g[..., None])[..., 0], axis=-1)
    bc = chunk(beta[..., None])[..., 0]
    incl, strict = masks()
    diff = G[..., :, None] - G[..., None, :]
    decay = jnp.where(incl, jnp.exp(jnp.where(incl, diff, 0.0)), 0.0)
    A = jnp.where(strict, jnp.einsum('nbhld,nbhmd->nbhlm', kc, kc) * decay, 0.0) * bc[..., :, None]
    IA = A + jnp.eye(CHUNK, dtype=A.dtype)
    rhs = jnp.concatenate([bc[..., None] * vc, (bc * jnp.exp(G))[..., None] * kc], axis=-1)
    sol = lax.linalg.triangular_solve(IA, rhs, left_side=True, lower=True, unit_diagonal=True)
    U0, Wk = sol[..., :HEAD_DIM], sol[..., HEAD_DIM:]
    qk = jnp.einsum('nbhld,nbhmd->nbhlm', qc, kc) * decay
    q_dec = qc * jnp.exp(G)[..., None]
    k_end = kc * jnp.exp(G[..., -1:] - G)[..., None]
    c_dec = jnp.exp(G[..., -1])

    def step(S, inp):
        qk_n, qd_n, ke_n, U0_n, W_n, cd_n = inp
        U = U0_n - jnp.einsum('bhld,bhde->bhle', W_n, S)
        o = jnp.einsum('bhld,bhde->bhle', qd_n, S) + jnp.einsum('bhlm,bhme->bhle', qk_n, U)
        S = cd_n[..., None, None] * S + jnp.einsum('bhld,bhle->bhde', ke_n, U)
        return S, o

    S_fin, o = lax.scan(step, S0, (qk, q_dec, k_end, U0, Wk, c_dec))
    return unchunk(o), S_fin


def retention_scan(q, k, v, log_gamma, S0):
    qc, kc, vc = chunk(q), chunk(k), chunk(v)
    idx = jnp.arange(CHUNK, dtype=jnp.float32)
    incl, _ = masks()
    lg = log_gamma.astype(jnp.float32)[:, None]
    decay = jnp.where(incl, jnp.exp(lg[..., None] * jnp.maximum(idx[:, None] - idx[None, :], 0.0)), 0.0)
    inner = jnp.einsum('nbhlm,nbhme->nbhle', jnp.einsum('nbhld,nbhmd->nbhlm', qc, kc) * decay, vc)
    q_dec = qc * jnp.exp(lg * (idx + 1.0))[..., None]
    k_end = kc * jnp.exp(lg * (CHUNK - 1.0 - idx))[..., None]
    c_dec = jnp.exp(lg * CHUNK)[..., None]

    def step(S, inp):
        qd, ke, vn = inp
        o = jnp.einsum('bhld,bhde->bhle', qd, S)
        S = c_dec * S + jnp.einsum('bhld,bhle->bhde', ke, vn)
        return S, o

    S_fin, cross = lax.scan(step, S0, (q_dec, k_end, vc))
    return unchunk(inner + cross), S_fin


def short_conv(x, w):
    ch = x.shape[-1]
    return lax.conv_general_dilated(x, w.astype(x.dtype)[:, None, :], window_strides=(1,),
                                    padding=[(CONV_K // 2, CONV_K // 2)],
                                    dimension_numbers=('NWC', 'WIO', 'NWC'), feature_group_count=ch)


def rope_tables(T):
    n_rows = T // GRID_W
    pos_r = jnp.repeat(jnp.arange(n_rows), GRID_W).astype(jnp.float32)
    pos_c = jnp.tile(jnp.arange(GRID_W), n_rows).astype(jnp.float32)
    nf = HEAD_DIM // 4
    freqs = ROPE_BASE ** (-jnp.arange(nf, dtype=jnp.float32) / nf)
    ang = jnp.concatenate([pos_r[:, None] * freqs, pos_c[:, None] * freqs], axis=-1)
    ang = jnp.concatenate([ang, ang], axis=-1)[:, None, :]
    return jnp.cos(ang), jnp.sin(ang)


def apply_rope(x, cs):
    cos, sin = cs
    x1, x2 = x[..., :HEAD_DIM // 2], x[..., HEAD_DIM // 2:]
    return x * cos + jnp.concatenate([-x2, x1], axis=-1) * sin


def swiglu(h, w13, w2):
    a, b = jnp.split(h @ w13, 2, axis=-1)
    return (jax.nn.silu(a) * b) @ w2


def token_mixing(h, states, rope, w_in, b_in, f_bias, conv_w, A_log, dt_bias, log_gamma, hn_g, w_br, w_out):
    f32 = jnp.float32
    Bsz, T, _ = h.shape
    P = (h @ w_in + b_in).astype(f32)
    qA, kA, vA, oA, iA, fA, qkvB, zB, betaB, aB, qC, kC, vC, gC, gm = jnp.split(P, IN_OFFSETS, axis=-1)
    C0, n0, m0, SD0, SR0 = [s.astype(f32) for s in states]
    qA = heads(qA, H_A)
    kA = heads(kA, H_A) * HEAD_DIM ** -0.5
    vA = heads(vA, H_A)
    iA = iA.reshape(Bsz, T, 2, H_A)
    lfA = jax.nn.log_sigmoid(fA.reshape(Bsz, T, 2, H_A) + f_bias.astype(f32))
    hf, Cf, nf, mf = mlstm_scan(qA, kA, vA, iA[:, :, 0], lfA[:, :, 0], C0[:, 0], n0[:, 0], m0[:, 0])
    hb, Cb, nb, mb = mlstm_scan(flip(qA), flip(kA), flip(vA), flip(iA[:, :, 1]), flip(lfA[:, :, 1]),
                                C0[:, 1], n0[:, 1], m0[:, 1])
    yA = head_rms(hf + flip(hb), hn_g[0]) * jax.nn.sigmoid(heads(oA, H_A))
    qkvB = jax.nn.silu(short_conv(qkvB, conv_w))
    qB, kB, vB = jnp.split(qkvB, 3, axis=-1)
    qB = l2norm(heads(qB, H_B)) * HEAD_DIM ** -0.5
    kB = l2norm(heads(kB, H_B))
    vB = heads(vB, H_B)
    beta = jax.nn.sigmoid(betaB.reshape(Bsz, T, 2, H_B))
    gB = -jnp.exp(A_log.astype(f32)) * jax.nn.softplus(aB.reshape(Bsz, T, 2, H_B) + dt_bias.astype(f32))
    of, SDf = delta_scan(qB, kB, vB, gB[:, :, 0], beta[:, :, 0], SD0[:, 0])
    ob, SDb = delta_scan(flip(qB), flip(kB), flip(vB), flip(gB[:, :, 1]), flip(beta[:, :, 1]), SD0[:, 1])
    yB = head_rms(of + flip(ob), hn_g[1]) * jax.nn.silu(heads(zB, H_B))
    qC = heads(qC, H_C) * HEAD_DIM ** -0.5
    kC = heads(kC, H_C)
    vC = heads(vC, H_C)
    if rope is not None:
        qC = apply_rope(qC, rope)
        kC = apply_rope(kC, rope)
    rf, SRf = retention_scan(qC, kC, vC, log_gamma[0], SR0[:, 0])
    rb, SRb = retention_scan(flip(qC), flip(kC), flip(vC), log_gamma[1], SR0[:, 1])
    yC = head_rms(rf + flip(rb), hn_g[2]) * jax.nn.silu(heads(gC, H_C))
    ys = jnp.stack([yA.reshape(Bsz, T, W_MIX), yB.reshape(Bsz, T, W_MIX), yC.reshape(Bsz, T, W_MIX)], axis=2).astype(h.dtype)
    br = jnp.einsum('btiw,iwd->btid', ys, w_br)
    gates = jax.nn.sigmoid(gm.reshape(Bsz, T, 3, -1)).astype(h.dtype)
    out = jnp.sum(gates * br, axis=2) @ w_out
    new_states = (jnp.stack([Cf, Cb], axis=1), jnp.stack([nf, nb], axis=1), jnp.stack([mf, mb], axis=1),
                  jnp.stack([SDf, SDb], axis=1), jnp.stack([SRf, SRb], axis=1))
    return out, new_states


def adaln(cv, w, b):
    return (jax.nn.silu(cv) @ w + b).reshape(cv.shape[0], N_MOD, -1)


def trunk_layer(x, ada, states, rope, norm_g, w_in, b_in, f_bias, conv_w, A_log, dt_bias, log_gamma,
                hn_g, w_br, w_out, w13, w2):
    mod = [ada[:, i][:, None, :] for i in range(N_MOD)]
    h = rmsnorm(x, norm_g[0]) * (1.0 + mod[1]) + mod[0]
    x = x + 0.5 * mod[2] * swiglu(h, w13[0], w2[0])
    h = rmsnorm(x, norm_g[1]) * (1.0 + mod[4]) + mod[3]
    out, new_states = token_mixing(h, states, rope, w_in, b_in, f_bias, conv_w, A_log, dt_bias, log_gamma,
                                   hn_g, w_br, w_out)
    x = x + mod[5] * out
    h = rmsnorm(x, norm_g[2]) * (1.0 + mod[7]) + mod[6]
    x = x + 0.5 * mod[8] * swiglu(h, w13[1], w2[1])
    return x, new_states


def setup_inputs(seed: int = 0) -> dict:
    key = jax.random.key(seed)
    ks = jax.random.split(key, 32)
    nrm = jax.random.normal
    D = D_MODEL
    sd = D ** -0.5
    f_bias = jnp.linspace(3.0, 6.0, H_A)[None, None, :] + 0.1 * nrm(ks[13], (DEPTH, 2, H_A))
    dt = jnp.exp(jax.random.uniform(ks[16], (DEPTH, 2, H_B), minval=np.log(0.001), maxval=np.log(0.1)))
    base_lg = jnp.log(1.0 - 2.0 ** (-5.0 - jnp.arange(H_C, dtype=jnp.float32)))
    return {
        'x_prompt': nrm(ks[0], (BATCH, SEQ, D)),
        'x_sample': nrm(ks[1], (DEC_BATCH, DEC_SEQ, D)),
        'state_mlstm_C': 0.1 * nrm(ks[2], (DEC_BATCH, DEPTH, 2, H_A, HEAD_DIM, HEAD_DIM)),
        'state_mlstm_n': 0.1 * nrm(ks[3], (DEC_BATCH, DEPTH, 2, H_A, HEAD_DIM)),
        'state_mlstm_m': nrm(ks[4], (DEC_BATCH, DEPTH, 2, H_A)),
        'state_delta_S': 0.1 * nrm(ks[5], (DEC_BATCH, DEPTH, 2, H_B, HEAD_DIM, HEAD_DIM)),
        'state_ret_S': 0.5 * nrm(ks[6], (DEC_BATCH, DEPTH, 2, H_C, HEAD_DIM, HEAD_DIM)),
        'c': nrm(ks[7], (DEC_BATCH, D)),
        'c_ctx': nrm(ks[8], (D,)),
        'norm_g': 1.0 + 0.02 * nrm(ks[9], (DEPTH, 3, D)),
        'final_norm_g': 1.0 + 0.02 * nrm(ks[10], (D,)),
        'w_ada': 0.5 * sd * nrm(ks[11], (DEPTH, D, N_MOD * D)),
        'b_ada': 0.02 * nrm(ks[12], (DEPTH, N_MOD * D)),
        'w_in': sd * nrm(ks[14], (DEPTH, D, N_IN)),
        'b_in': 0.02 * nrm(ks[15], (DEPTH, N_IN)),
        'mlstm_f_bias': f_bias,
        'conv_w': CONV_K ** -0.5 * nrm(ks[17], (DEPTH, CONV_K, 3 * W_MIX)),
        'delta_A_log': jnp.log(jax.random.uniform(ks[18], (DEPTH, 2, H_B), minval=1.0, maxval=16.0)),
        'delta_dt_bias': dt + jnp.log(-jnp.expm1(-dt)),
        'ret_log_gamma': base_lg[None, None, :] * (1.0 + 0.05 * nrm(ks[19], (DEPTH, 2, H_C))),
        'head_norm_g': 1.0 + 0.02 * nrm(ks[20], (DEPTH, 3, HEAD_DIM)),
        'w_br': W_MIX ** -0.5 * nrm(ks[21], (DEPTH, 3, W_MIX, D)),
        'w_out': sd * nrm(ks[22], (DEPTH, D, D)),
        'ffn_w13': sd * nrm(ks[23], (DEPTH, 2, D, 2 * D_FF)),
        'ffn_w2': D_FF ** -0.5 * nrm(ks[24], (DEPTH, 2, D_FF, D)),
    }


def reference(x_prompt, x_sample, state_mlstm_C, state_mlstm_n, state_mlstm_m, state_delta_S, state_ret_S,
              c, c_ctx, norm_g, final_norm_g, w_ada, b_ada, w_in, b_in, mlstm_f_bias, conv_w, delta_A_log,
              delta_dt_bias, ret_log_gamma, head_norm_g, w_br, w_out, ffn_w13, ffn_w2):
    f32 = jnp.float32
    Bp = x_prompt.shape[0]
    zero_states = (jnp.zeros((Bp, 2, H_A, HEAD_DIM, HEAD_DIM), f32), jnp.zeros((Bp, 2, H_A, HEAD_DIM), f32),
                   jnp.zeros((Bp, 2, H_A), f32), jnp.zeros((Bp, 2, H_B, HEAD_DIM, HEAD_DIM), f32),
                   jnp.zeros((Bp, 2, H_C, HEAD_DIM, HEAD_DIM), f32))
    rope = rope_tables(x_sample.shape[1])
    xp, xs = x_prompt, x_sample
    ctx_states = []
    for l in range(DEPTH):
        lw = (norm_g[l], w_in[l], b_in[l], mlstm_f_bias[l], conv_w[l], delta_A_log[l], delta_dt_bias[l],
              ret_log_gamma[l], head_norm_g[l], w_br[l], w_out[l], ffn_w13[l], ffn_w2[l])
        xp, st = trunk_layer(xp, adaln(c_ctx[None, :], w_ada[l], b_ada[l]), zero_states, None, *lw)
        ctx_states.append(st)
        cache_l = (state_mlstm_C[:, l], state_mlstm_n[:, l], state_mlstm_m[:, l], state_delta_S[:, l], state_ret_S[:, l])
        xs, _ = trunk_layer(xs, adaln(c, w_ada[l], b_ada[l]), cache_l, rope, *lw)
    y_prompt = rmsnorm(xp, final_norm_g)
    y_sample = rmsnorm(xs, final_norm_g)
    dt_out = x_prompt.dtype
    new_mlstm_C = jnp.stack([s[0] for s in ctx_states], axis=1).astype(dt_out)
    new_mlstm_n = jnp.stack([s[1] for s in ctx_states], axis=1).astype(dt_out)
    new_mlstm_m = jnp.stack([s[2] for s in ctx_states], axis=1).astype(dt_out)
    new_delta_S = jnp.stack([s[3] for s in ctx_states], axis=1).astype(dt_out)
    new_ret_S = jnp.stack([s[4] for s in ctx_states], axis=1).astype(dt_out)
    return (y_prompt, y_sample, new_mlstm_C, new_mlstm_n, new_mlstm_m, new_delta_S, new_ret_S)
```

```cpp
#include <hip/hip_runtime.h>
#include <cstdio>
#include <cstdint>

#define XB_TMO      128
#define XB_XCNT(j)  (256  + 64 * (j))
#define XB_XSUB(j)  (1280 + 64 * (j))
#define XB_XGEN(j)  (2304 + 64 * (j))
#define XB_TOP      3328
#define XB_TOPGEN   3392
#define XCD_BAR_WORDS 3456
#define XB_SPIN_CAP (1u << 18)
#define LAS __attribute__((address_space(3)))

__device__ __forceinline__ unsigned xb_ld(unsigned* p)              { return __hip_atomic_load(p, __ATOMIC_RELAXED, __HIP_MEMORY_SCOPE_AGENT); }
__device__ __forceinline__ unsigned xb_add(unsigned* p, unsigned v) { return __hip_atomic_fetch_add(p, v, __ATOMIC_RELAXED, __HIP_MEMORY_SCOPE_AGENT); }
__device__ __forceinline__ unsigned xb_xcc_id() { return (unsigned)__builtin_amdgcn_s_getreg((3 << 11) | 20) & 0xFu; }
#define XB_SPIN(cond, bar) do { unsigned _sp = 0; while (cond) { __builtin_amdgcn_s_sleep(1); \
    if ((++_sp & 255u) == 0u) { if (xb_ld(&(bar)[XB_TMO])) break; if (_sp > XB_SPIN_CAP) { atomicAdd(&(bar)[XB_TMO], 1u); break; } } } } while (0)

struct XcdBarrier {
    unsigned* bar; unsigned x;
    volatile LAS unsigned* st;
};

__device__ __forceinline__ XcdBarrier xcd_barrier_post(unsigned* bar, volatile LAS unsigned* st) {
    XcdBarrier b; b.bar = bar; b.x = xb_xcc_id(); b.st = st;
    if (threadIdx.x == 0) (void)xb_add(&bar[XB_XCNT(b.x)], 1u);
    return b;
}
__device__ __forceinline__ void xcd_barrier_complete(unsigned* bar, unsigned x, unsigned& nloc, unsigned& nx) {
    const unsigned G = gridDim.x * gridDim.y * gridDim.z;
    unsigned sum, cnt, mine, sp = 0u;
    for (;;) {
        sum = 0u; cnt = 0u; mine = 0u;
#pragma unroll
        for (unsigned j = 0; j < 16; ++j) { const unsigned c = xb_ld(&bar[XB_XCNT(j)]); sum += c; cnt += (c > 0u) ? 1u : 0u; mine = (j == x) ? c : mine; }
        if (sum == G) break;
        __builtin_amdgcn_s_sleep(1);
        if ((++sp & 255u) == 0u) { if (xb_ld(&bar[XB_TMO])) break; if (sp > XB_SPIN_CAP) { atomicAdd(&bar[XB_TMO], 1u); break; } }
    }
    nloc = mine > 0u ? mine : 1u; nx = cnt > 0u ? cnt : 1u;
}

__device__ __forceinline__ void xcd_barrier(const XcdBarrier& b) {
    asm volatile("s_waitcnt vmcnt(0)" ::: "memory");
    __syncthreads();
    if (threadIdx.x == 0) {
        unsigned* bar = b.bar;
        __builtin_amdgcn_s_waitcnt(0);
        unsigned nloc = b.st[0], nx = b.st[1];
        if (nloc == 0u) { xcd_barrier_complete(bar, b.x, nloc, nx); b.st[0] = nloc; b.st[1] = nx; }
        const unsigned old = xb_add(&bar[XB_XSUB(b.x)], 1u);
        const unsigned gen = old / nloc;
        if (old + 1u == (gen + 1u) * nloc) {
            __builtin_amdgcn_fence(__ATOMIC_RELEASE, "agent");
            asm volatile("s_waitcnt vmcnt(0)" ::: "memory");
            const unsigned og = xb_add(&bar[XB_TOP], 1u);
            const unsigned tg = og / nx;
            if (og + 1u == (tg + 1u) * nx) xb_add(&bar[XB_TOPGEN], 1u);
            else XB_SPIN(xb_ld(&bar[XB_TOPGEN]) == tg, bar);
            __builtin_amdgcn_fence(__ATOMIC_ACQUIRE, "agent");
            xb_add(&bar[XB_XGEN(b.x)], 1u);
            asm volatile("s_waitcnt vmcnt(0)" ::: "memory");
        } else {
            XB_SPIN(xb_ld(&bar[XB_XGEN(b.x)]) == gen, bar);
            __builtin_amdgcn_fence(__ATOMIC_ACQUIRE, "agent");
            asm volatile("s_waitcnt vmcnt(0)" ::: "memory");
        }
    }
    __syncthreads();
}


namespace pg8 {
#define PG8_LAS __attribute__((address_space(3)))
typedef unsigned short bf16_t;
typedef short bf16x8 __attribute__((ext_vector_type(8)));
typedef float f32x4 __attribute__((ext_vector_type(4)));
typedef unsigned u32x4 __attribute__((ext_vector_type(4)));
typedef unsigned u32x2 __attribute__((ext_vector_type(2)));
constexpr int BM = 256, BK = 64, HALF = 128, HTB = HALF * BK * 2  , STAGE_BYTES = 8 * HTB, NXCD = 8, WGM = 4;

__host__ __device__ __forceinline__ int lds_byte(int r, int c) { const int st = (r >> 4) * 2 + (c >> 5), rr = r & 15, cc = c & 31, ob = rr * 64 + cc * 2; return st * 1024 + (ob ^ (((ob >> 9) & 1) << 5)); }
__host__ __device__ __forceinline__ void stage_rc(int b, int& R, int& C) { const int st = b / 1024, sb = b % 1024, swz = sb ^ (((sb >> 9) & 1) << 5); R = (st >> 1) * 16 + swz / 64; C = (st & 1) * 32 + (swz % 64) / 2; }
__host__ __device__ __forceinline__ int perm32(int rho) { const int n = rho >> 4, i = rho & 15; return 8 * (i >> 2) + 4 * n + (i & 3); }

struct Unit { int pm, pn; };
struct Gemm { const bf16_t* A; const bf16_t* Bt; int M, N, K; };

struct StaticOrder {
    int nM, nN, nwg, G, c, wgm;
    __host__ __device__ void init(int M, int N, int G_, int c_, int wgm_ = WGM) { nM = M / BM; nN = N / BM; nwg = nM * nN; G = G_; c = c_; wgm = wgm_; }
    __host__ __device__ bool next(int i, Unit& u) const {
        const long L = (long)i * G + c; if (L >= nwg) return false;
        int wgid = (int)L; { const int q = nwg / NXCD, r = nwg % NXCD, xcd = wgid % NXCD, off = wgid / NXCD; wgid = (xcd < r ? xcd * (q + 1) : r * (q + 1) + (xcd - r) * q) + off; }
        const int nig = wgm * nN, gid = wgid / nig, fm = gid * wgm, gsz = (nM - fm) < wgm ? (nM - fm) : wgm;
        u.pm = fm + ((wgid % nig) % gsz); u.pn = (wgid % nig) / gsz; return true;
    }
    __device__ __forceinline__ void a_ready(const Unit&) const {}
    __device__ __forceinline__ void done(const Unit&) const {}
};

typedef __bf16 bf16x2_t __attribute__((ext_vector_type(2)));
typedef float f32x2_t __attribute__((ext_vector_type(2)));
__device__ __forceinline__ unsigned cvt_pk_bf16(float lo, float hi) { const f32x2_t v = {lo, hi}; const bf16x2_t b = __builtin_convertvector(v, bf16x2_t); return __builtin_bit_cast(unsigned, b); }
__device__ __forceinline__ float fsigmoid(float x) { return __builtin_amdgcn_rcpf(1.0f + __expf(-x)); }
__device__ __forceinline__ float fsilu(float x) { return x * __builtin_amdgcn_rcpf(1.0f + __expf(-x)); }
__device__ __forceinline__ float bflo(unsigned w) { return __uint_as_float(w << 16); }
__device__ __forceinline__ float bfhi(unsigned w) { return __uint_as_float(w & 0xffff0000u); }

struct EpiSwiglu {
    static constexpr bool PERM = true, AFTER_DRAIN = false;
    bf16_t* O; int ldo; const float* SS; const float* shW;
    __device__ __forceinline__ void operator()(const f32x4 (&acc)[2][2][4][2], const Unit& u, int wr, int wc, int fr, int fq) const {
        const int row0 = u.pm * BM + wr * 64 + fr, col0 = u.pn * HALF + wc * 32 + 8 * fq;
        const int rb = u.pm < 16 ? 0 : (u.pm < 32 ? 1 : 2);
        const float* sw = shW + (size_t)rb * 8192 + u.pn * BM + wc * 32 + 8 * fq;
        const f32x4 sa0 = *(const f32x4*)sw, sa1 = *(const f32x4*)(sw + 4), sb0 = *(const f32x4*)(sw + HALF), sb1 = *(const f32x4*)(sw + HALF + 4);
        float rstdv[2][4];
#pragma unroll
        for (int ai = 0; ai < 2; ++ai)
#pragma unroll
            for (int m = 0; m < 4; ++m) rstdv[ai][m] = rsqrtf(SS[row0 + ai * HALF + m * 16] * (1.0f / 2048.0f) + 1e-6f);
#pragma unroll
        for (int ai = 0; ai < 2; ++ai)
#pragma unroll
            for (int m = 0; m < 4; ++m) {
                const int row = row0 + ai * HALF + m * 16;
                const float rstd = rstdv[ai][m];
                bf16_t* rowp = O + (size_t)row * ldo + col0;
                const f32x4 a0 = acc[ai][0][m][0] * rstd + sa0, a1 = acc[ai][0][m][1] * rstd + sa1, b0 = acc[ai][1][m][0] * rstd + sb0, b1 = acc[ai][1][m][1] * rstd + sb1;
                u32x4 w;
                w.x = cvt_pk_bf16(fsilu(a0[0]) * b0[0], fsilu(a0[1]) * b0[1]); w.y = cvt_pk_bf16(fsilu(a0[2]) * b0[2], fsilu(a0[3]) * b0[3]);
                w.z = cvt_pk_bf16(fsilu(a1[0]) * b1[0], fsilu(a1[1]) * b1[1]); w.w = cvt_pk_bf16(fsilu(a1[2]) * b1[2], fsilu(a1[3]) * b1[3]);
                *(u32x4*)rowp = w;
            }
    }
};
template <int MODIDX, bool HALFSCALE> struct EpiResid {
    static constexpr bool PERM = true, AFTER_DRAIN = false;
    static constexpr int modidx = MODIDX; static constexpr float scale = HALFSCALE ? 0.5f : 1.0f;
    float* X; const float* ada;
    const float* Xrp; const float* Xrs;
    bf16_t* XB; const float* gnext; const float* scnext; float* SS; int has_xb;
    __device__ __forceinline__ void operator()(const f32x4 (&acc)[2][2][4][2], const Unit& u, int wr, int wc, int fr, int fq) const {
        const int rb = u.pm < 16 ? 0 : (u.pm < 32 ? 1 : 2);
        const float* mv = ada + (size_t)(rb * 9 + modidx) * 2048;
        const int row0 = u.pm * BM + wr * 64 + fr, col0 = u.pn * BM + wc * 32 + 8 * fq;
        f32x4 mvv[2][2], gsv[2][2];
#pragma unroll
        for (int bj = 0; bj < 2; ++bj)
#pragma unroll
            for (int n = 0; n < 2; ++n) { const int c = col0 + bj * HALF + n * 4; mvv[bj][n] = *(const f32x4*)(mv + c) * scale;
                gsv[bj][n] = has_xb ? *(const f32x4*)(gnext + c) * (*(const f32x4*)(scnext + (size_t)rb * 9 * 2048 + c) + 1.0f) : (f32x4){0.f, 0.f, 0.f, 0.f}; }
#pragma unroll
        for (int ai = 0; ai < 2; ++ai)
#pragma unroll
            for (int mp = 0; mp < 2; ++mp) {
                f32x4 xr[2][2][2];
#pragma unroll
                for (int mm = 0; mm < 2; ++mm)
#pragma unroll
                    for (int bj = 0; bj < 2; ++bj) { const size_t row = (size_t)(row0 + ai * HALF + (2 * mp + mm) * 16);
                        const f32x4* r0 = (const f32x4*)((u.pm < 16 ? Xrp : Xrs) + row * 2048 + col0 + bj * HALF); xr[mm][bj][0] = r0[0]; xr[mm][bj][1] = r0[1]; }
#pragma unroll
                for (int mm = 0; mm < 2; ++mm) { const int m = 2 * mp + mm; const size_t row = (size_t)(row0 + ai * HALF + m * 16); float* rowp = X + row * 2048 + col0; float ssq = 0.f;
#pragma unroll
                    for (int bj = 0; bj < 2; ++bj) {
                        f32x4* p0 = (f32x4*)(rowp + bj * HALF); f32x4* p1 = p0 + 1;
                        const f32x4 x0 = xr[mm][bj][0] + mvv[bj][0] * acc[ai][bj][m][0], x1 = xr[mm][bj][1] + mvv[bj][1] * acc[ai][bj][m][1];
                        *p0 = x0; *p1 = x1;
                        ssq += ((x0[0] * x0[0] + x0[1] * x0[1]) + (x0[2] * x0[2] + x0[3] * x0[3])) + ((x1[0] * x1[0] + x1[1] * x1[1]) + (x1[2] * x1[2] + x1[3] * x1[3]));
                        if (has_xb) { const f32x4 y0 = x0 * gsv[bj][0], y1 = x1 * gsv[bj][1];
                            u32x4 w; w.x = cvt_pk_bf16(y0[0], y0[1]); w.y = cvt_pk_bf16(y0[2], y0[3]); w.z = cvt_pk_bf16(y1[0], y1[1]); w.w = cvt_pk_bf16(y1[2], y1[3]);
                            *(u32x4*)(XB + row * 2048 + col0 + bj * HALF) = w; } }
                    ssq += __shfl_xor(ssq, 16); ssq += __shfl_xor(ssq, 32);
                    if (fq == 0) atomicAdd(SS + row, ssq); }
            }
    }
};
struct EpiWin {
    static constexpr bool PERM = true, AFTER_DRAIN = false;
    bf16_t* PQ; bf16_t* PG; float* GT; const float* biasp; const float* SS; const float* shW;
    __device__ __forceinline__ void operator()(const f32x4 (&acc)[2][2][4][2], const Unit& u, int wr, int wc, int fr, int fq) const {
        const int pn = u.pn, row0 = u.pm * BM + wr * 64 + fr, tc = wc * 32 + 8 * fq;
        f32x4 bv[2][2];
#pragma unroll
        for (int bj = 0; bj < 2; ++bj)
#pragma unroll
            for (int n = 0; n < 2; ++n) bv[bj][n] = *(const f32x4*)(biasp + pn * BM + bj * HALF + tc + 4 * n) + *(const f32x4*)(shW + (size_t)(u.pm < 16 ? 0 : (u.pm < 32 ? 1 : 2)) * 18688 + pn * BM + bj * HALF + tc + 4 * n);
        float rstd[2][4];
#pragma unroll
        for (int ai = 0; ai < 2; ++ai)
#pragma unroll
            for (int m = 0; m < 4; ++m) rstd[ai][m] = rsqrtf(SS[row0 + ai * HALF + m * 16] * (1.0f / 2048.0f) + 1e-6f);
        if (pn == 72) {
            if (wc < 2) {
#pragma unroll
                for (int ai = 0; ai < 2; ++ai)
#pragma unroll
                    for (int m = 0; m < 4; ++m) { float* rowp = GT + (size_t)(row0 + ai * HALF + m * 16) * 64 + tc;
                        *(f32x4*)rowp = acc[ai][0][m][0] * rstd[ai][m] + bv[0][0]; *(f32x4*)(rowp + 4) = acc[ai][0][m][1] * rstd[ai][m] + bv[0][1]; }
            }
            return;
        }
        bf16_t* base; int colt, act;
        if (pn < 36) { base = PQ; colt = pn * BM; act = 0; } else { const int q = pn - 36; base = PG; colt = q * BM; act = (q < 4) ? 1 : ((q < 12) ? 2 : 1); }
#pragma unroll
        for (int ai = 0; ai < 2; ++ai)
#pragma unroll
            for (int m = 0; m < 4; ++m) { bf16_t* rowp = base + (size_t)(row0 + ai * HALF + m * 16) * 9216 + colt + tc;
#pragma unroll
                for (int bj = 0; bj < 2; ++bj) { f32x4 v0 = acc[ai][bj][m][0] * rstd[ai][m] + bv[bj][0], v1 = acc[ai][bj][m][1] * rstd[ai][m] + bv[bj][1];
                    if (act == 1) {
#pragma unroll
                        for (int j = 0; j < 4; ++j) { v0[j] = fsigmoid(v0[j]); v1[j] = fsigmoid(v1[j]); } }
                    else if (act == 2) {
#pragma unroll
                        for (int j = 0; j < 4; ++j) { v0[j] = fsilu(v0[j]); v1[j] = fsilu(v1[j]); } }
                    u32x4 w; w.x = cvt_pk_bf16(v0[0], v0[1]); w.y = cvt_pk_bf16(v0[2], v0[3]); w.z = cvt_pk_bf16(v1[0], v1[1]); w.w = cvt_pk_bf16(v1[2], v1[3]);
                    *(u32x4*)(rowp + bj * HALF) = w; } }
    }
};
struct EpiBr {
    static constexpr bool PERM = true, AFTER_DRAIN = false;
    const bf16_t* PG; float* TMP; bf16_t* OUT; int seg;
    __device__ __forceinline__ void operator()(const f32x4 (&acc)[2][2][4][2], const Unit& u, int wr, int wc, int fr, int fq) const {
        const int row0 = u.pm * BM + wr * 64 + fr, col0 = u.pn * BM + wc * 32 + 8 * fq;
#pragma unroll
        for (int ai = 0; ai < 2; ++ai)
#pragma unroll
            for (int mp = 0; mp < 2; ++mp) {
                u32x4 gwv[2][2], tv[2][2];
#pragma unroll
                for (int mm = 0; mm < 2; ++mm)
#pragma unroll
                    for (int bj = 0; bj < 2; ++bj) { const size_t row = (size_t)(row0 + ai * HALF + (2 * mp + mm) * 16); const int c = col0 + bj * HALF;
                        gwv[mm][bj] = *(const u32x4*)(PG + row * 9216 + 3072 + seg * 2048 + c);
                        tv[mm][bj] = (seg != 0) ? *(const u32x4*)(OUT + row * 2048 + c) : (u32x4){0u, 0u, 0u, 0u}; }
#pragma unroll
                for (int mm = 0; mm < 2; ++mm)
#pragma unroll
                    for (int bj = 0; bj < 2; ++bj) { const int m = 2 * mp + mm; const size_t row = (size_t)(row0 + ai * HALF + m * 16); const int c = col0 + bj * HALF;
                        const u32x4 gw = gwv[mm][bj], t = tv[mm][bj];
                        f32x4 v0 = acc[ai][bj][m][0], v1 = acc[ai][bj][m][1];
                        v0[0] = v0[0] * bflo(gw.x) + bflo(t.x); v0[1] = v0[1] * bfhi(gw.x) + bfhi(t.x); v0[2] = v0[2] * bflo(gw.y) + bflo(t.y); v0[3] = v0[3] * bfhi(gw.y) + bfhi(t.y);
                        v1[0] = v1[0] * bflo(gw.z) + bflo(t.z); v1[1] = v1[1] * bfhi(gw.z) + bfhi(t.z); v1[2] = v1[2] * bflo(gw.w) + bflo(t.w); v1[3] = v1[3] * bfhi(gw.w) + bfhi(t.w);
                        u32x4 w; w.x = cvt_pk_bf16(v0[0], v0[1]); w.y = cvt_pk_bf16(v0[2], v0[3]); w.z = cvt_pk_bf16(v1[0], v1[1]); w.w = cvt_pk_bf16(v1[2], v1[3]);
                        *(u32x4*)(OUT + row * 2048 + c) = w; }
            }
    }
};

template <class Epi, class Sched, bool ALIGN_EPI = false, bool SP2 = false>
__device__ __forceinline__ void gemm_phase(PG8_LAS unsigned char* lds, const Gemm g, const Sched& S, const Epi& E) {
    int tid_raw = threadIdx.x; asm volatile("" : "+v"(tid_raw));
    const int tid = tid_raw, wid = __builtin_amdgcn_readfirstlane(tid >> 6), lane = tid & 63, wr = wid >> 2, wc = wid & 3, fr = lane & 15, fq = lane >> 4;
    const int K = g.K, nt = K / BK;
    unsigned voffA[2], voffB[2];
#pragma unroll
    for (int i = 0; i < 2; ++i) { int R, C; stage_rc(tid * 16 + i * 8192, R, C); const int Rb = Epi::PERM ? ((R & ~31) + perm32(R & 31)) : R;
        voffA[i] = (unsigned)(R * K + C) * 2u; voffB[i] = (unsigned)(Rb * K + C) * 2u; }
    const size_t kstep = (size_t)(BK * 2);
    const size_t hstep = (size_t)HALF * K * 2;
    const size_t tstep = 2 * hstep;
    const unsigned ldsw = (unsigned)wid * 1024u;
    const int aoff = lds_byte(wr * 64 + fr, fq * 8), boff = lds_byte(wc * 32 + fr, fq * 8);
#define PG8_SA(b, h) (((b) * 2 + (h)) * HTB)
#define PG8_SB(b, h) ((4 + (b) * 2 + (h)) * HTB)
#define PG8_STAGE(bufoff, gbase, voff) do { _Pragma("unroll") for (int _i = 0; _i < 2; ++_i) \
        __builtin_amdgcn_global_load_lds((const unsigned*)((const char*)(gbase) + (voff)[_i]), (PG8_LAS unsigned*)(lds + (bufoff) + ldsw + _i * 8192), 16, 0, 0); } while (0)
#define PG8_LDA(dst, b, h) do { _Pragma("unroll") for (int m = 0; m < 4; ++m) _Pragma("unroll") for (int k = 0; k < 2; ++k) dst[m][k] = *(const PG8_LAS bf16x8*)(lds + PG8_SA(b, h) + aoff + m * 2048 + k * 1024); } while (0)
#define PG8_LDB(dst, b, h) do { _Pragma("unroll") for (int n = 0; n < 2; ++n) _Pragma("unroll") for (int k = 0; k < 2; ++k) dst[n][k] = *(const PG8_LAS bf16x8*)(lds + PG8_SB(b, h) + boff + n * 2048 + k * 1024); } while (0)
#define PG8_MMA(ai, bj, At, Bt) do { __builtin_amdgcn_s_setprio(1); _Pragma("unroll") for (int m = 0; m < 4; ++m) _Pragma("unroll") for (int n = 0; n < 2; ++n) _Pragma("unroll") for (int k = 0; k < 2; ++k) \
        acc[ai][bj][m][n] = __builtin_amdgcn_mfma_f32_16x16x32_bf16(Bt[n][k], At[m][k], acc[ai][bj][m][n], 0, 0, 0); __builtin_amdgcn_s_setprio(0); } while (0)
#define PG8_WAIT_V(n) asm volatile("s_waitcnt vmcnt(" #n ")" ::: "memory")
#define PG8_WAIT_L(n) asm volatile("s_waitcnt lgkmcnt(" #n ")" ::: "memory")
#define PG8_BAR __builtin_amdgcn_s_barrier()
#define PG8_SCHED __builtin_amdgcn_sched_barrier(0)
    Unit cur, nxt; int ui = 0;
    if (!S.next(0, cur)) return;
    f32x4 acc[2][2][4][2];
#pragma unroll
    for (int a = 0; a < 2; ++a)
#pragma unroll
        for (int b = 0; b < 2; ++b)
#pragma unroll
            for (int m = 0; m < 4; ++m)
#pragma unroll
                for (int n = 0; n < 2; ++n) acc[a][b][m][n] = (f32x4){0.f, 0.f, 0.f, 0.f};
    bf16x8 At[4][2], B0[2][2], B1[2][2];
    const char* cA = (const char*)g.A + (size_t)cur.pm * tstep; const char* cB = (const char*)g.Bt + (size_t)cur.pn * tstep;
    S.a_ready(cur);
    if constexpr (SP2) {
        PG8_STAGE(PG8_SB(0, 0), cB, voffB); PG8_STAGE(PG8_SB(0, 1), cB + hstep, voffB); PG8_STAGE(PG8_SA(0, 0), cA, voffA); PG8_STAGE(PG8_SA(0, 1), cA + hstep, voffA);
        if (wr == 1) PG8_BAR;
        PG8_WAIT_V(2); PG8_BAR;
        PG8_STAGE(PG8_SB(1, 0), cB + kstep, voffB); PG8_STAGE(PG8_SA(1, 0), cA + kstep, voffA); PG8_STAGE(PG8_SB(1, 1), cB + hstep + kstep, voffB);
        PG8_WAIT_V(6); PG8_BAR;
    } else {
        PG8_STAGE(PG8_SB(0, 0), cB, voffB); PG8_STAGE(PG8_SA(0, 0), cA, voffA); PG8_STAGE(PG8_SB(0, 1), cB + hstep, voffB); PG8_STAGE(PG8_SA(0, 1), cA + hstep, voffA);
        if (wr == 1) PG8_BAR;
        PG8_WAIT_V(4); PG8_BAR;
        PG8_STAGE(PG8_SB(1, 0), cB + kstep, voffB); PG8_STAGE(PG8_SA(1, 0), cA + kstep, voffA); PG8_STAGE(PG8_SB(1, 1), cB + hstep + kstep, voffB);
        PG8_WAIT_V(6); PG8_BAR;
    }
    for (;;) {
        const bool has_next = S.next(ui + 1, nxt);
        const char* nA = has_next ? (const char*)g.A + (size_t)nxt.pm * tstep : cA; const char* nB = has_next ? (const char*)g.Bt + (size_t)nxt.pn * tstep : cB;
        for (int t = 0; t < nt; t += 2) {
            const bool last = (t == nt - 2);
            const char* a1 = cA + (size_t)(t + 1) * kstep;
            const char* a2 = last ? nA : cA + (size_t)(t + 2) * kstep; const char* b2 = last ? nB : cB + (size_t)(t + 2) * kstep;
            const char* a3 = a2 + kstep; const char* b3 = b2 + kstep;
            if (last && has_next) S.a_ready(nxt);
            if constexpr (SP2) {
            PG8_LDB(B0, 0, 0); PG8_LDB(B1, 0, 1); PG8_SCHED; PG8_LDA(At, 0, 0); PG8_STAGE(PG8_SA(1, 1), a1 + hstep, voffA);
            PG8_WAIT_V(8); PG8_WAIT_L(0); PG8_BAR; PG8_MMA(0, 0, At, B0); PG8_MMA(0, 1, At, B1); PG8_BAR; PG8_SCHED;
            PG8_LDA(At, 0, 1); PG8_STAGE(PG8_SB(0, 0), b2, voffB); PG8_STAGE(PG8_SB(0, 1), b2 + hstep, voffB); PG8_STAGE(PG8_SA(0, 0), a2, voffA);
            PG8_WAIT_V(8); PG8_WAIT_L(0); PG8_BAR; PG8_MMA(1, 0, At, B0); PG8_MMA(1, 1, At, B1); PG8_BAR; PG8_SCHED;
            PG8_LDB(B0, 1, 0); PG8_LDB(B1, 1, 1); PG8_SCHED; PG8_LDA(At, 1, 0); PG8_STAGE(PG8_SA(0, 1), a2 + hstep, voffA);
            PG8_WAIT_V(8); PG8_WAIT_L(0); PG8_BAR; PG8_MMA(0, 0, At, B0); PG8_MMA(0, 1, At, B1); PG8_BAR; PG8_SCHED;
            PG8_LDA(At, 1, 1); PG8_STAGE(PG8_SB(1, 0), b3, voffB); PG8_STAGE(PG8_SB(1, 1), b3 + hstep, voffB); PG8_STAGE(PG8_SA(1, 0), a3, voffA);
            PG8_WAIT_V(8); PG8_WAIT_L(0); PG8_BAR; PG8_MMA(1, 0, At, B0); PG8_MMA(1, 1, At, B1); PG8_BAR; PG8_SCHED;
            } else {
            PG8_LDB(B0, 0, 0); PG8_SCHED; PG8_LDA(At, 0, 0); PG8_STAGE(PG8_SA(1, 1), a1 + hstep, voffA);
            PG8_WAIT_L(8); PG8_BAR; PG8_WAIT_L(0); PG8_MMA(0, 0, At, B0); PG8_BAR; PG8_SCHED;
            PG8_LDB(B1, 0, 1); PG8_STAGE(PG8_SB(0, 0), b2, voffB);
            PG8_BAR; PG8_WAIT_L(0); PG8_MMA(0, 1, At, B1); PG8_BAR;
            PG8_LDA(At, 0, 1); PG8_STAGE(PG8_SA(0, 0), a2, voffA);
            PG8_BAR; PG8_WAIT_L(0); PG8_MMA(1, 0, At, B0); PG8_BAR; PG8_SCHED;
            PG8_STAGE(PG8_SB(0, 1), b2 + hstep, voffB);
            PG8_WAIT_V(6); PG8_BAR; PG8_MMA(1, 1, At, B1); PG8_BAR;
            PG8_LDB(B0, 1, 0); PG8_SCHED; PG8_LDA(At, 1, 0); PG8_STAGE(PG8_SA(0, 1), a2 + hstep, voffA);
            PG8_WAIT_L(8); PG8_BAR; PG8_WAIT_L(0); PG8_MMA(0, 0, At, B0); PG8_BAR; PG8_SCHED;
            PG8_LDB(B1, 1, 1); PG8_STAGE(PG8_SB(1, 0), b3, voffB);
            PG8_BAR; PG8_WAIT_L(0); PG8_MMA(0, 1, At, B1); PG8_BAR;
            PG8_LDA(At, 1, 1); PG8_STAGE(PG8_SA(1, 0), a3, voffA);
            PG8_BAR; PG8_WAIT_L(0); PG8_MMA(1, 0, At, B0); PG8_BAR; PG8_SCHED;
            PG8_STAGE(PG8_SB(1, 1), b3 + hstep, voffB);
            PG8_WAIT_V(6); PG8_BAR; PG8_MMA(1, 1, At, B1); PG8_BAR;
            }
        }
        if constexpr (ALIGN_EPI) { if (wr == 0) PG8_BAR; }
        if constexpr (!Epi::AFTER_DRAIN) { E(acc, cur, wr, wc, fr, fq); S.done(cur); }
        if (!has_next) break;
#pragma unroll
        for (int a = 0; a < 2; ++a)
#pragma unroll
            for (int b = 0; b < 2; ++b)
#pragma unroll
                for (int m = 0; m < 4; ++m)
#pragma unroll
                    for (int n = 0; n < 2; ++n) acc[a][b][m][n] = (f32x4){0.f, 0.f, 0.f, 0.f};
        cur = nxt; cA = nA; cB = nB; ++ui;
        if constexpr (ALIGN_EPI) { if (wr == 1) PG8_BAR; }
    }
    PG8_WAIT_V(0);
    if constexpr (!ALIGN_EPI) { if (wr == 0) PG8_BAR; }
    PG8_BAR;
    if constexpr (Epi::AFTER_DRAIN) { E.fused(acc, cur, wr, wc, fr, fq, lds, wid, lane); S.done(cur); }
#undef PG8_SA
#undef PG8_SB
#undef PG8_STAGE
#undef PG8_LDA
#undef PG8_LDB
#undef PG8_MMA
#undef PG8_WAIT_V
#undef PG8_WAIT_L
#undef PG8_BAR
#undef PG8_SCHED
}
}

using pg8::bf16_t; using pg8::bf16x8; using pg8::f32x4; using pg8::u32x4; using pg8::u32x2;
using pg8::cvt_pk_bf16; using pg8::bflo; using pg8::bfhi; using pg8::fsigmoid; using pg8::fsilu;

#ifndef ONE_LAUNCH
#define ONE_LAUNCH 1
#define PROBE_SCAN_MASK 7
#define PROBE_SEG 0
#define PROBE_PREP 0
#define WGM_WIN 4
#define WGM_UP 4
#define WGM_N2K 4
#define PROBE_BAR 0

#endif

constexpr int DM = 2048, MROWS = 12288, NTHREADS = 512, NWAVES = 8;
constexpr int NINP = 18688, NIN = 18496;
constexpr int LDQ = 9216;
constexpr float EPS = 1e-6f;
constexpr float QSCALE = 0.08838834764831845f;

enum { I_XP = 0, I_XS, I_SC, I_SN, I_SM, I_SD, I_SR, I_C, I_CCTX, I_NORMG, I_FNG, I_WADA, I_BADA, I_WIN, I_BIN, I_FBIAS, I_CONVW, I_ALOG, I_DTB, I_LGAM, I_HNG, I_WBR, I_WOUT, I_W13, I_W2, N_INPUTS };

constexpr size_t OUT_Y = 0, OUT_C = 25165824, OUT_N = OUT_C + 8388608, OUT_M = OUT_N + 65536, OUT_DS = OUT_M + 512, OUT_RS = OUT_DS + 8388608, OUT_TOTAL = OUT_RS + 8388608;

constexpr size_t MiB = 1u << 20;
constexpr size_t WS_CTL = 0, CTL_BYTES = 2 * MiB;
constexpr size_t WS_QUEUE = 32768;
constexpr size_t WS_ADA = 65536;
constexpr size_t WS_SS = 512 * 1024;
constexpr size_t WS_SHW = 1 * MiB;
constexpr int SHW_LAYER = 105216, SHW_WIN = 24576, SHW_UP1 = 80640;
constexpr size_t WS_ROPE = 2 * MiB;
constexpr size_t WS_BIASP = WS_ROPE + 16384;
constexpr size_t WS_W13T = 3 * MiB;
constexpr size_t WS_W2T = WS_W13T + 64 * MiB;
constexpr size_t WS_WINT = WS_W2T + 32 * MiB;
constexpr size_t WS_WBRT = WS_WINT + 73 * MiB;
constexpr size_t WS_WOUTT = WS_WBRT + 12 * MiB;
constexpr size_t WS_PQ = WS_WOUTT + 8 * MiB;
constexpr size_t WS_PG = WS_PQ + 216 * MiB;
constexpr size_t WS_GT = WS_PG + 216 * MiB;
constexpr size_t WS_QN = WS_GT + 3 * MiB;
constexpr size_t WS_KT = WS_QN + 24 * MiB;
constexpr size_t WS_U0T = WS_KT + 24 * MiB;
constexpr size_t WS_WK = WS_U0T + 48 * MiB;
constexpr size_t WS_QKD = WS_WK + 48 * MiB;
constexpr size_t WS_GCH = WS_QKD + 24 * MiB;
constexpr size_t WS_HS = WS_GCH + 1 * MiB;
constexpr size_t WS_W1 = WS_HS + 144 * MiB;
constexpr size_t WS_BIASP1 = WS_W1 + 189 * MiB;
constexpr size_t WS_END = WS_BIASP1 + 1 * MiB;
__host__ __device__ constexpr size_t wofs(int l) { return l ? (WS_W1 - WS_W13T) : 0; }
constexpr size_t WS_HID = WS_PQ, WS_YS = WS_PQ, WS_TMP = WS_PQ + 76 * MiB, WS_H = WS_HS, WS_XB3 = WS_PQ + 100 * MiB;

constexpr int LDS_BYTES = 147456, LDS_WORK = LDS_BYTES - 64;

struct Params { const float* in[N_INPUTS]; float* out; unsigned char* ws; };

struct Frame { int tid, wid, lane, bid, G; LAS unsigned char* lds; unsigned char* ws; float* out; };

__device__ __forceinline__ int sp(int i, int dir) { return dir ? 63 - i : i; }
__device__ __forceinline__ f32x4 mfma16(bf16x8 a, bf16x8 b, f32x4 c) { return __builtin_amdgcn_mfma_f32_16x16x32_bf16(a, b, c, 0, 0, 0); }
template <int K> __device__ __forceinline__ f32x4 mm16(f32x4 acc, const LAS bf16_t* A, int lda, const LAS bf16_t* Bt, int ldb, int lane) {
    const int r = lane & 15, kq = (lane >> 4) * 8;
#pragma unroll
    for (int k0 = 0; k0 < K; k0 += 32) {
        const bf16x8 a = *(const LAS bf16x8*)(A + r * lda + k0 + kq);
        const bf16x8 b = *(const LAS bf16x8*)(Bt + r * ldb + k0 + kq);
        acc = mfma16(a, b, acc);
    }
    return acc;
}
__device__ __forceinline__ bf16_t f2bf(float f) { return (bf16_t)(cvt_pk_bf16(f, 0.f) & 0xffffu); }
__device__ __forceinline__ u32x2 pack4(f32x4 v) { u32x2 w; w.x = cvt_pk_bf16(v[0], v[1]); w.y = cvt_pk_bf16(v[2], v[3]); return w; }
__device__ __forceinline__ void unpack8(u32x4 w, float (&x)[8]) { x[0] = bflo(w.x); x[1] = bfhi(w.x); x[2] = bflo(w.y); x[3] = bfhi(w.y); x[4] = bflo(w.z); x[5] = bfhi(w.z); x[6] = bflo(w.w); x[7] = bfhi(w.w); }
__device__ __forceinline__ u32x4 pack8(const float (&x)[8]) { u32x4 w; w.x = cvt_pk_bf16(x[0], x[1]); w.y = cvt_pk_bf16(x[2], x[3]); w.z = cvt_pk_bf16(x[4], x[5]); w.w = cvt_pk_bf16(x[6], x[7]); return w; }
template <int CTRL, int ROWMASK> __device__ __forceinline__ float dppf(float old, float x) {
    return __builtin_bit_cast(float, __builtin_amdgcn_update_dpp(__builtin_bit_cast(int, old), __builtin_bit_cast(int, x), CTRL, ROWMASK, 0xF, false));
}
__device__ __forceinline__ float wave_scan_add(float x, int) {
    x += dppf<0x111, 0xF>(0.f, x); x += dppf<0x112, 0xF>(0.f, x); x += dppf<0x114, 0xF>(0.f, x); x += dppf<0x118, 0xF>(0.f, x);
    x += dppf<0x142, 0xA>(0.f, x); x += dppf<0x143, 0xC>(0.f, x);
    return x;
}
__device__ __forceinline__ float wave_scan_max(float x, int) {
    const float ninf = -__builtin_huge_valf();
    x = fmaxf(x, dppf<0x111, 0xF>(ninf, x)); x = fmaxf(x, dppf<0x112, 0xF>(ninf, x)); x = fmaxf(x, dppf<0x114, 0xF>(ninf, x)); x = fmaxf(x, dppf<0x118, 0xF>(ninf, x));
    x = fmaxf(x, dppf<0x142, 0xA>(ninf, x)); x = fmaxf(x, dppf<0x143, 0xC>(ninf, x));
    return x;
}

__device__ __forceinline__ float wave_sum(float s) {
#pragma unroll
    for (int o = 32; o >= 1; o >>= 1) s += __shfl_xor(s, o);
    return s;
}
__device__ __forceinline__ void phase_copy_norm(const Params& p, const Frame& f) {
    bf16_t* H = (bf16_t*)(f.ws + WS_H); float* SS = (float*)(f.ws + WS_SS);
    const float* g = p.in[I_NORMG]; const float* ada = (const float*)(f.ws + WS_ADA);
    for (int row = f.bid * NWAVES + f.wid; row < MROWS; row += f.G * NWAVES) {
        const int rb = row < 4096 ? 0 : (row < 8192 ? 1 : 2);
        const float* xs = (row < 4096) ? p.in[I_XP] + (size_t)row * 2048 : p.in[I_XS] + (size_t)(row - 4096) * 2048;
        const float* scl = ada + (size_t)(rb * 9 + 1) * 2048;
        f32x4 v[8]; float ss = 0.f;
#pragma unroll
        for (int it = 0; it < 8; ++it) { v[it] = *(const f32x4*)(xs + 4 * (f.lane + 64 * it)); ss += v[it][0] * v[it][0] + v[it][1] * v[it][1] + v[it][2] * v[it][2] + v[it][3] * v[it][3]; }
        ss = wave_sum(ss);
        if (f.lane == 0) SS[row] = ss;
#pragma unroll
        for (int it = 0; it < 8; ++it) { const int c = 4 * (f.lane + 64 * it);
            const f32x4 y = v[it] * *(const f32x4*)(g + c) * (*(const f32x4*)(scl + c) + 1.0f);
            *(u32x2*)(H + (size_t)row * 2048 + c) = pack4(y); }
    }
}
__device__ __forceinline__ void phase_rope(const Params& p, const Frame& f) {
    float* rope = (float*)(f.ws + WS_ROPE);
    for (int i = f.bid * NTHREADS + f.tid; i < 64 * 32; i += f.G * NTHREADS) {
        const int pos = i >> 5, fi = i & 31;
        const float freq = powf(10000.0f, -(float)fi / 32.0f), ang = (float)pos * freq;
        float s, c; sincosf(ang, &s, &c);
        rope[2 * i] = c; rope[2 * i + 1] = s;
    }
}
__device__ __forceinline__ void phase_ada(const Params& p, int l, int w, int nw, const Frame& f, int ilo = 0, int ihi = 9 * 128) {
    LAS float* sc = (LAS float*)f.lds;
    float* ada = (float*)(f.ws + WS_ADA);
#pragma unroll 1
    for (int item = ilo + w; item < ihi; item += nw) {
        const int g = item >> 7, kp = item & 127;
        __syncthreads();
        if (f.tid < 48) { const int r = f.tid >> 4, k = kp * 16 + (f.tid & 15);
            const float cv = (r == 0) ? p.in[I_CCTX][k] : p.in[I_C][(r - 1) * 2048 + k];
            sc[f.tid] = fsilu(cv); }
        __syncthreads();
        const int col = g * 2048 + f.tid * 4;
        const float* W = p.in[I_WADA] + ((size_t)l * 2048 + (size_t)kp * 16) * 18432 + col;
        f32x4 a0 = {0.f, 0.f, 0.f, 0.f}, a1 = a0, a2 = a0;
#pragma unroll
        for (int k = 0; k < 16; ++k) { const f32x4 w4 = *(const f32x4*)(W + (size_t)k * 18432); a0 += w4 * sc[k]; a1 += w4 * sc[16 + k]; a2 += w4 * sc[32 + k]; }
        if (kp == 0) { const f32x4 b = *(const f32x4*)(p.in[I_BADA] + (size_t)l * 18432 + col); a0 += b; a1 += b; a2 += b; }
        float* o = ada + (size_t)l * 3 * 18432 + col;
#pragma unroll
        for (int j = 0; j < 4; ++j) { atomicAdd(o + j, a0[j]); atomicAdd(o + 18432 + j, a1[j]); atomicAdd(o + 2 * 18432 + j, a2[j]); }
    }
}
__device__ __forceinline__ int win_src_col(int n) {
    if (n < 3072) return n;
    if (n < 6144) return 4128 + (n - 3072);
    if (n < 9216) return 8256 + (n - 6144);
    if (n < 10240) return 3072 + (n - 9216);
    if (n < 11264) return 7200 + (n - 10240);
    if (n < 12288) return 11328 + (n - 11264);
    if (n < 18432) return 12352 + (n - 12288);
    if (n < 18464) return 4096 + (n - 18432);
    if (n < 18496) return 8224 + (n - 18464);
    return -1;
}
__device__ __forceinline__ void convert_bias(const Params& p, int l, int first, int stride, const Frame& f) {
    float* biasp = (float*)(f.ws + (l ? WS_BIASP1 : WS_BIASP));
    for (int i = first * NTHREADS + f.tid; i < NINP; i += stride * NTHREADS) { const int s = win_src_col(i); biasp[i] = (s >= 0) ? p.in[I_BIN][(size_t)l * NIN + s] : 0.f; }
}
__device__ __forceinline__ void convert_item(const Params& p, int l, int item, const Frame& f) {
    {
        const size_t wo = wofs(l);
        const float* src; bf16_t* dst; int K, Nsrc, nb, kb, kind; const float* shp = nullptr; float* shd = nullptr; int shn = 0;
        if (item < 512) { const int j = item >> 8, r = item & 255; nb = r >> 1; kb = r & 1; K = 2048; Nsrc = 8192; kind = 0;
            src = p.in[I_W13] + (size_t)(l * 2 + j) * 2048 * 8192; dst = (bf16_t*)(f.ws + wo + WS_W13T) + (size_t)j * 8192 * 2048;
            shp = (const float*)(f.ws + WS_ADA) + (size_t)l * 3 * 18432 + (size_t)(j == 0 ? 0 : 6) * 2048; shd = (float*)(f.ws + WS_SHW) + (size_t)l * SHW_LAYER + (j == 0 ? 0 : SHW_UP1); shn = 8192; }
        else if (item < 768) { const int it = item - 512, j = it >> 7, r = it & 127; nb = r >> 2; kb = r & 3; K = 4096; Nsrc = 2048; kind = 1;
            src = p.in[I_W2] + (size_t)(l * 2 + j) * 4096 * 2048; dst = (bf16_t*)(f.ws + wo + WS_W2T) + (size_t)j * 2048 * 4096; }
        else if (item < 1352) { const int it = item - 768; nb = it >> 1; kb = it & 1; K = 2048; Nsrc = NIN; kind = 2;
            src = p.in[I_WIN] + (size_t)l * 2048 * NIN; dst = (bf16_t*)(f.ws + wo + WS_WINT);
            shp = (const float*)(f.ws + WS_ADA) + (size_t)l * 3 * 18432 + (size_t)3 * 2048; shd = (float*)(f.ws + WS_SHW) + (size_t)l * SHW_LAYER + SHW_WIN; shn = NINP; }
        else if (item < 1448) { const int it = item - 1352, j = it >> 5; nb = it & 31; kb = 0; K = 1024; Nsrc = 2048; kind = 1;
            src = p.in[I_WBR] + (size_t)(l * 3 + j) * 1024 * 2048; dst = (bf16_t*)(f.ws + wo + WS_WBRT) + (size_t)j * 2048 * 1024; }
        else { const int it = item - 1448; nb = it >> 1; kb = it & 1; K = 2048; Nsrc = 2048; kind = 1;
            src = p.in[I_WOUT] + (size_t)l * 2048 * 2048; dst = (bf16_t*)(f.ws + wo + WS_WOUTT); }
        const int nd = nb * 64 + f.lane;
        int scol;
        if (kind == 0) scol = ((nd >> 7) & 1) * 4096 + (nd >> 8) * 128 + (nd & 127);
        else if (kind == 1) scol = nd;
        else scol = win_src_col(nd);
        const int k0 = kb * 1024 + f.wid * 128;
        const float* sp0 = src + (size_t)k0 * Nsrc + (scol >= 0 ? scol : 0);
        bf16_t* dp = dst + (size_t)nd * K + k0;
        float dsh0 = 0.f, dsh1 = 0.f, dsh2 = 0.f;
#pragma unroll 1
        for (int kk = 0; kk < 128; kk += 64) {
            float v[64];
#pragma unroll
            for (int j = 0; j < 64; ++j) v[j] = sp0[(size_t)(kk + j) * Nsrc];
            if (scol < 0) {
#pragma unroll
                for (int j = 0; j < 64; ++j) v[j] = 0.f; }
            if (shp) { const float* s0 = shp + k0 + kk; const float* s1 = s0 + 9 * 2048; const float* s2 = s1 + 9 * 2048;
#pragma unroll
                for (int j = 0; j < 64; ++j) { dsh0 += v[j] * s0[j]; dsh1 += v[j] * s1[j]; dsh2 += v[j] * s2[j]; } }
#pragma unroll
            for (int q = 0; q < 8; ++q) {
                u32x4 w;
                w.x = cvt_pk_bf16(v[8 * q + 0], v[8 * q + 1]); w.y = cvt_pk_bf16(v[8 * q + 2], v[8 * q + 3]); w.z = cvt_pk_bf16(v[8 * q + 4], v[8 * q + 5]); w.w = cvt_pk_bf16(v[8 * q + 6], v[8 * q + 7]);
                *(u32x4*)(dp + kk + 8 * q) = w;
            }
        }
        if (shp && scol >= 0) { atomicAdd(shd + nd, dsh0); atomicAdd(shd + shn + nd, dsh1); atomicAdd(shd + 2 * shn + nd, dsh2); }
    }
}
constexpr int CONV_ITEMS = 1512;
__device__ __forceinline__ void convert_range(const Params& p, int l, int lo, int hi, int w, int nw, const Frame& f) {
#pragma unroll 1
    for (int item = lo + w; item < hi; item += nw) convert_item(p, l, item, f);
}
__device__ __forceinline__ void convert_first_set(const Params& p, int l, int w, int nw, const Frame& f) {
    convert_bias(p, l, w, nw, f);
    convert_range(p, l, 0, 256, w, nw, f); convert_range(p, l, 512, 640, w, nw, f);
    if (l != 0) convert_range(p, l, 1280, 1352, w, nw, f);
}
__device__ __forceinline__ void convert_fill(const Params& p, int l, int slot, const Frame& f) {
    if (f.G != 256) return;
    if (slot == 6) { if (f.bid >= 176) convert_range(p, l, 1352, 1512, f.bid - 176, 80, f); return; }
    if (f.bid < 128) return;
    const int w = f.bid - 128;
    if (slot == 0) convert_range(p, l, 768, l == 0 ? 1352 : 1280, w, 128, f);
    else if (slot == 1) convert_range(p, l, 256, 384, w, 128, f);
    else if (slot == 2) convert_range(p, l, 384, 512, w, 128, f);
    else if (slot == 3) { if (l == 0) phase_ada(p, 1, w, 128, f); }
    else if (slot == 4) convert_range(p, l, 640, 768, w, 128, f);
    else if (slot == 5 && l == 0) convert_first_set(p, 1, w, 128, f);
}
__device__ __forceinline__ void phase_convert(const Params& p, int l, const Frame& f) {
    if (f.G == 256) { if (l == 0) convert_first_set(p, 0, f.bid, f.G, f); }
    else { convert_bias(p, l, f.bid, f.G, f); convert_range(p, l, 0, CONV_ITEMS, f.bid, f.G, f); }
}

__device__ __forceinline__ void phase_final_norm(const Params& p, const Frame& f) {
    float* X = f.out + OUT_Y; const float* SS = (const float*)(f.ws + WS_SS) + (size_t)6 * MROWS;
    const size_t n = (size_t)MROWS * 512, stride = (size_t)f.G * NTHREADS;
    const size_t ifirst = (size_t)f.bid * NTHREADS + f.tid;
    const f32x4 gv = *(const f32x4*)(p.in[I_FNG] + (int)(ifirst & 511) * 4);
    f32x4 xa[4], xb[4]; float ra[4], rb[4];
#define FN_LOAD(x, rs, i0) _Pragma("unroll") for (int k = 0; k < 4; ++k) { const size_t i = (i0) + k * stride; if (i < n) { x[k] = *(const f32x4*)(X + (i >> 9) * 2048 + (i & 511) * 4); rs[k] = SS[i >> 9]; } }
#define FN_STORE(x, rs, i0) _Pragma("unroll") for (int k = 0; k < 4; ++k) { const size_t i = (i0) + k * stride; if (i < n) *(f32x4*)(X + (i >> 9) * 2048 + (i & 511) * 4) = x[k] * rsqrtf(rs[k] * (1.0f / 2048.0f) + EPS) * gv; }
    size_t i0 = ifirst;
    if (i0 >= n) return;
    FN_LOAD(xa, ra, i0)
    for (;;) {
        const size_t i1 = i0 + 4 * stride;
        if (i1 < n) { FN_LOAD(xb, rb, i1) }
        FN_STORE(xa, ra, i0)
        if (i1 >= n) break;
        const size_t i2 = i1 + 4 * stride;
        if (i2 < n) { FN_LOAD(xa, ra, i2) }
        FN_STORE(xb, rb, i1)
        if (i2 >= n) break;
        i0 = i2;
    }
#undef FN_LOAD
#undef FN_STORE
}

__device__ __forceinline__ void phase_merge(const Params& p, int l, const Frame& f) {
    const bf16_t* HS = (const bf16_t*)(f.ws + WS_HS); const bf16_t* PG = (const bf16_t*)(f.ws + WS_PG); bf16_t* YS = (bf16_t*)(f.ws + WS_YS);
    const float* hng = p.in[I_HNG] + (size_t)l * 3 * 128;
    const int c0 = 16 * f.lane, rstride = f.G * NWAVES;
    u32x4 A[3][6], B[3][6];
#define MG_LOAD(R, row) _Pragma("unroll") for (int mx = 0; mx < 3; ++mx) { \
        const bf16_t* pf = HS + ((size_t)(mx * 2 + 0) * MROWS + (row)) * 1024 + c0; const bf16_t* pb = HS + ((size_t)(mx * 2 + 1) * MROWS + (row)) * 1024 + c0; \
        const bf16_t* pgt = PG + (size_t)(row) * LDQ + mx * 1024 + c0; \
        R[mx][0] = *(const u32x4*)pf; R[mx][1] = *(const u32x4*)(pf + 8); R[mx][2] = *(const u32x4*)pb; R[mx][3] = *(const u32x4*)(pb + 8); \
        R[mx][4] = *(const u32x4*)pgt; R[mx][5] = *(const u32x4*)(pgt + 8); }
#define MG_COMP(R, row) _Pragma("unroll") for (int mx = 0; mx < 3; ++mx) { \
        float a[8], b[8], s[16], gt[16]; \
        unpack8(R[mx][0], a); unpack8(R[mx][2], b); \
        _Pragma("unroll") for (int j = 0; j < 8; ++j) s[j] = a[j] + b[j]; \
        unpack8(R[mx][1], a); unpack8(R[mx][3], b); \
        _Pragma("unroll") for (int j = 0; j < 8; ++j) s[8 + j] = a[j] + b[j]; \
        unpack8(R[mx][4], a); unpack8(R[mx][5], b); \
        _Pragma("unroll") for (int j = 0; j < 8; ++j) { gt[j] = a[j]; gt[8 + j] = b[j]; } \
        float ss = 0.f; \
        _Pragma("unroll") for (int j = 0; j < 16; ++j) ss += s[j] * s[j]; \
        ss += __shfl_xor(ss, 1); ss += __shfl_xor(ss, 2); ss += __shfl_xor(ss, 4); \
        const float rs = rsqrtf(ss * (1.0f / 128.0f) + EPS); \
        const float* hg = hng + mx * 128 + (c0 & 127); \
        float o[8]; \
        _Pragma("unroll") for (int j = 0; j < 8; ++j) o[j] = s[j] * rs * hg[j] * gt[j]; \
        bf16_t* po = YS + ((size_t)mx * MROWS + (row)) * 1024 + c0; \
        *(u32x4*)po = pack8(o); \
        _Pragma("unroll") for (int j = 0; j < 8; ++j) o[j] = s[8 + j] * rs * hg[8 + j] * gt[8 + j]; \
        *(u32x4*)(po + 8) = pack8(o); }
    int row = f.bid * NWAVES + f.wid;
    if (row >= MROWS) return;
    MG_LOAD(A, row)
    for (;;) {
        const int r1 = row + rstride;
        if (r1 < MROWS) { MG_LOAD(B, r1) }
        MG_COMP(A, row)
        if (r1 >= MROWS) break;
        const int r2 = r1 + rstride;
        if (r2 < MROWS) { MG_LOAD(A, r2) }
        MG_COMP(B, r1)
        if (r2 >= MROWS) break;
        row = r2;
    }
#undef MG_LOAD
#undef MG_COMP
}

constexpr int PA = 144, PB = 80;
typedef short v4i16_t __attribute__((ext_vector_type(4)));
__device__ __forceinline__ bf16x8 rd_frag(const LAS bf16_t* X, int pitch, int row0, int k0, int lane) {
    return *(const LAS bf16x8*)(X + (row0 + (lane & 15)) * pitch + k0 + 8 * (lane >> 4));
}
__device__ __forceinline__ bf16x8 tr_frag(const LAS bf16_t* X, int pitch, int t0, int c0, int lane) {
    const LAS bf16_t* a = X + (t0 + 8 * (lane >> 4) + ((lane & 15) >> 2)) * pitch + c0 + 4 * (lane & 3);
    const v4i16_t lo = __builtin_amdgcn_ds_read_tr16_b64_v4i16((LAS v4i16_t*)a);
    const v4i16_t hi = __builtin_amdgcn_ds_read_tr16_b64_v4i16((LAS v4i16_t*)(a + 4 * pitch));
    bf16x8 f; f[0] = lo[0]; f[1] = lo[1]; f[2] = lo[2]; f[3] = lo[3]; f[4] = hi[0]; f[5] = hi[1]; f[6] = hi[2]; f[7] = hi[3];
    return f;
}

constexpr int PR_KN = 0, PR_V = 18432, PR_ASC = 36864, PR_KK = 69632, PR_QN = 86272, PR_T1 = 69632, PR_T2 = 90112, PR_GS = 110592, PR_BS = 111104,
              PR_TU = 111616, PR_A21 = 121856, PR_XT = 126976, PR_CW = 132096, PR_END = 136704,
              PR_AD = 36864, PR_A21S = 45056, PR_T22S = 50176, PR_XTS = 55296;
static_assert(PR_END <= LDS_BYTES - 64, "prep LDS map");
struct PrepLoads { u32x4 r[3][6]; float gb, ga; };
__device__ __forceinline__ void prep_issue_loads(PrepLoads& L, const bf16_t* PQ, const float* GT, int item, int tid, int lane, int wid) {
    const int gc = item >> 3, h = item & 7, row0 = gc * 64;
    const bool first = (gc < 64) ? ((gc & 3) == 0) : (((gc - 64) & 63) == 0);
    const bool last = (gc < 64) ? ((gc & 3) == 3) : (((gc - 64) & 63) == 63);
    const int i = tid >> 3, s = tid & 7, row = row0 + i;
    const bool okm = (i > 0) || !first, okp = (i < 63) || !last;
    const u32x4 z = {0u, 0u, 0u, 0u};
#pragma unroll
    for (int X = 0; X < 3; ++X) {
        const bf16_t* src = PQ + (size_t)row * LDQ + 3072 + X * 1024 + h * 128 + 8 * s;
        L.r[X][0] = okm ? *(const u32x4*)(src - LDQ) : z; L.r[X][1] = *(const u32x4*)src; L.r[X][2] = okp ? *(const u32x4*)(src + LDQ) : z;
        L.r[X][3] = okm ? *(const u32x4*)(src - LDQ + 64) : z; L.r[X][4] = *(const u32x4*)(src + 64); L.r[X][5] = okp ? *(const u32x4*)(src + LDQ + 64) : z;
    }
    L.gb = 0.f; L.ga = 0.f;
    if (wid < 2) { const int dir = wid, r2 = row0 + sp(lane, dir); L.gb = GT[(size_t)r2 * 64 + 32 + dir * 8 + h]; L.ga = GT[(size_t)r2 * 64 + 48 + dir * 8 + h]; }
}
__device__ __forceinline__ void phase_delta_prep(const Params& p, int l, const Frame& f) {
    LAS bf16_t* kn = (LAS bf16_t*)(f.lds + PR_KN); LAS bf16_t* vv = (LAS bf16_t*)(f.lds + PR_V); LAS bf16_t* qn = (LAS bf16_t*)(f.lds + PR_QN);
    LAS float* KK = (LAS float*)(f.lds + PR_KK); LAS float* Ad = (LAS float*)(f.lds + PR_AD);
    LAS bf16_t* A21s = (LAS bf16_t*)(f.lds + PR_A21S); LAS bf16_t* T22s = (LAS bf16_t*)(f.lds + PR_T22S); LAS bf16_t* XTs = (LAS bf16_t*)(f.lds + PR_XTS);
    LAS float* Gs = (LAS float*)(f.lds + PR_GS); LAS float* bs = (LAS float*)(f.lds + PR_BS);
    LAS bf16_t* T1 = (LAS bf16_t*)(f.lds + PR_T1); LAS bf16_t* T2 = (LAS bf16_t*)(f.lds + PR_T2);
    LAS bf16_t* TU = (LAS bf16_t*)(f.lds + PR_TU); LAS bf16_t* A21 = (LAS bf16_t*)(f.lds + PR_A21); LAS bf16_t* XT = (LAS bf16_t*)(f.lds + PR_XT);
    const bf16_t* PQ = (const bf16_t*)(f.ws + WS_PQ); const float* GT = (const float*)(f.ws + WS_GT);
    bf16_t* QN = (bf16_t*)(f.ws + WS_QN); bf16_t* KNg = (bf16_t*)(f.ws + WS_KT); bf16_t* U0T = (bf16_t*)(f.ws + WS_U0T); bf16_t* WKg = (bf16_t*)(f.ws + WS_WK);
    bf16_t* QKD = (bf16_t*)(f.ws + WS_QKD); float* GCH = (float*)(f.ws + WS_GCH);
    const float* convw = p.in[I_CONVW] + (size_t)l * 3 * 3072;
    const int wid = f.wid;
    PrepLoads L;
    if (f.bid < 192 * 8) prep_issue_loads(L, PQ, GT, f.bid, f.tid, f.lane, wid);
    LAS float* cw = (LAS float*)(f.lds + PR_CW);
    for (int i = f.tid; i < (PR_XTS + 5120 - PR_A21S) / 4; i += NTHREADS) ((LAS unsigned*)(f.lds + PR_A21S))[i] = 0u;
    for (int i = f.tid; i < 10240 / 4; i += NTHREADS) ((LAS unsigned*)(f.lds + PR_TU))[i] = 0u;
    int hcur = -1;
#pragma unroll 1
    for (int item = f.bid; item < 192 * 8; item += f.G) {
        const int gc = item >> 3, h = item & 7, row0 = gc * 64, ch = gc * 8 + h;
        int tid = f.tid; asm volatile("" : "+v"(tid));
        const int lane = tid & 63;
        __syncthreads();
        if (h != hcur) {
            for (int i = f.tid; i < 3 * 384; i += NTHREADS) { const int tap = i / 384, c = i % 384; cw[i] = convw[tap * 3072 + (c >> 7) * 1024 + h * 128 + (c & 127)]; }
            hcur = h;
            __syncthreads();
        }
        {
            const int i = tid >> 3, s = tid & 7, row = row0 + i;
#pragma unroll
            for (int X = 0; X < 3; ++X) {
                const int cb = X * 1024 + h * 128 + 8 * s;
                float o1[8], o2[8];
                {
                    float xm[8], x0[8], xp[8];
                    unpack8(L.r[X][0], xm); unpack8(L.r[X][1], x0); unpack8(L.r[X][2], xp);
                    const LAS float* w = cw + X * 128 + 8 * s;
#pragma unroll
                    for (int j = 0; j < 8; ++j) o1[j] = fsilu(xm[j] * w[j] + x0[j] * w[384 + j] + xp[j] * w[768 + j]);
                    unpack8(L.r[X][3], xm); unpack8(L.r[X][4], x0); unpack8(L.r[X][5], xp);
#pragma unroll
                    for (int j = 0; j < 8; ++j) o2[j] = fsilu(xm[j] * w[64 + j] + x0[j] * w[384 + 64 + j] + xp[j] * w[768 + 64 + j]);
                }
                if (X < 2) {
                    float ss = 0.f;
#pragma unroll
                    for (int j = 0; j < 8; ++j) ss += o1[j] * o1[j] + o2[j] * o2[j];
                    ss += __shfl_xor(ss, 1); ss += __shfl_xor(ss, 2); ss += __shfl_xor(ss, 4);
                    const float scl = rsqrtf(ss + EPS) * (X == 0 ? QSCALE : 1.0f);
#pragma unroll
                    for (int j = 0; j < 8; ++j) { o1[j] *= scl; o2[j] *= scl; }
                }
                const u32x4 w1 = pack8(o1), w2 = pack8(o2);
                LAS bf16_t* T = (X == 0) ? qn : ((X == 1) ? kn : vv);
                *(LAS u32x4*)(T + i * PA + 8 * s) = w1; *(LAS u32x4*)(T + i * PA + 64 + 8 * s) = w2;
                if (X < 2) { bf16_t* g = ((X == 0) ? QN : KNg) + (size_t)row * 1024 + h * 128 + 8 * s; *(u32x4*)g = w1; *(u32x4*)(g + 64) = w2; }
            }
        }
        if (wid < 2) {
            const int dir = wid, i = sp(lane, dir);
            const float be = fsigmoid(L.gb);
            const float xa = L.ga + p.in[I_DTB][(l * 2 + dir) * 8 + h];
            const float spl = (xa > 20.f) ? xa : __logf(1.0f + __expf(xa));
            const float g = -__expf(p.in[I_ALOG][(l * 2 + dir) * 8 + h]) * spl;
            const float G = wave_scan_add(g, lane);
            Gs[dir * 64 + i] = G; bs[dir * 64 + i] = be;
            GCH[(size_t)(ch * 2 + dir) * 64 + i] = G;
        }
        if (item + f.G < 192 * 8) prep_issue_loads(L, PQ, GT, item + f.G, tid, lane, wid);
        __syncthreads();
#pragma unroll
        for (int t2 = 0; t2 < 2; ++t2) {
            const int tt = 2 * wid + t2, tm = tt >> 2, tn = tt & 3;
            f32x4 akk = {0.f, 0.f, 0.f, 0.f}, aqk = akk;
#pragma unroll
            for (int ks = 0; ks < 4; ++ks) {
                const bf16x8 a = rd_frag(kn, PA, 16 * tm, 32 * ks, lane);
                akk = mfma16(a, rd_frag(kn, PA, 16 * tn, 32 * ks, lane), akk);
                aqk = mfma16(a, rd_frag(qn, PA, 16 * tn, 32 * ks, lane), aqk);
            }
            const int r0 = 16 * tm + 4 * (lane >> 4), cc = 16 * tn + (lane & 15);
#pragma unroll
            for (int r = 0; r < 4; ++r) KK[(r0 + r) * 65 + cc] = akk[r];
#pragma unroll
            for (int dir = 0; dir < 2; ++dir) {
                const float Gi = Gs[dir * 64 + cc]; const int pi = sp(cc, dir);
                f32x4 v;
#pragma unroll
                for (int r = 0; r < 4; ++r) { const int j = r0 + r; const float e = aqk[r] * __expf(fminf(Gi - Gs[dir * 64 + j], 0.f)); v[r] = (sp(j, dir) <= pi) ? e : 0.f; }
                *(u32x2*)(QKD + (size_t)(ch * 2 + dir) * 4096 + cc * 64 + r0) = pack4(v);
            }
        }
        __syncthreads();
#pragma unroll 4
        for (int it = 0; it < 8; ++it) {
            const int e = tid + 512 * it, dir = e >> 11, kk = (e >> 6) & 31, sl = e & 63;
            const int pp = (sl < kk) ? kk : 63 - kk, p2 = (sl < kk) ? sl : sl - kk;
            if (p2 < pp) {
                const int i = sp(pp, dir), j = sp(p2, dir);
                const float a = bs[dir * 64 + i] * KK[i * 65 + j] * __expf(fminf(Gs[dir * 64 + i] - Gs[dir * 64 + j], 0.f));
                if (pp >= 32 && p2 < 32) A21[(dir * 32 + (pp - 32)) * 40 + p2] = f2bf(a);
                else if ((pp >> 4) == (p2 >> 4)) Ad[((dir * 4 + (pp >> 4)) * 16 + (pp & 15)) * 16 + (p2 & 15)] = a;
                else A21s[((dir * 2 + (pp >> 5)) * 16 + (pp & 15)) * 40 + (p2 & 15)] = f2bf(a);
            }
        }
        __syncthreads();
        {
            const int dir = wid >> 2, d16 = wid & 3, b = d16 >> 1, half = d16 & 1, c = lane & 15;
            const LAS float* A = Ad + (dir * 4 + d16) * 256;
            const int jn = sp(16 * d16 + c, dir); const float bj = bs[dir * 64 + jn], bg = bj * __expf(Gs[dir * 64 + jn]);
            LAS bf16_t* t1p = T1 + (dir * 64 + 16 * d16) * PB + jn; LAS bf16_t* t2p = T2 + (dir * 64 + 16 * d16) * PB + jn;
            LAS bf16_t* tup = TU + ((dir * 2 + b) * 32 + 16 * half) * 40 + 16 * half + c;
            LAS bf16_t* t22p = T22s + ((dir * 2 + b) * 16) * 40 + c;
            const int bc = d16 + (lane >> 4); const int jz = sp((16 * bc + c) & 63, dir);
            LAS bf16_t* z1p = T1 + (dir * 64 + 16 * d16) * PB + jz; LAS bf16_t* z2p = T2 + (dir * 64 + 16 * d16) * PB + jz;
            const bool wl = lane < 16, zl = (lane >= 16) && (bc <= 3);
            float ar[16];
#pragma unroll
            for (int r = 0; r < 16; ++r) ar[r] = A[r * 16 + c];
            float t[16];
#pragma unroll
            for (int r = 0; r < 16; ++r) {
                float ac[4] = {(r == c) ? 1.f : 0.f, 0.f, 0.f, 0.f};
#pragma unroll
                for (int j = 0; j < r; ++j) {
                    const float aj = __builtin_bit_cast(float, __builtin_amdgcn_readlane(__builtin_bit_cast(int, ar[r]), j));
                    ac[j & 3] -= aj * t[j];
                }
                const float acc = (ac[0] + ac[1]) + (ac[2] + ac[3]);
                t[r] = acc;
                if (wl) { t1p[r * PB] = f2bf(acc * bj); t2p[r * PB] = f2bf(acc * bg); tup[r * 40] = f2bf(acc); if (half) t22p[r * 40] = f2bf(acc); }
                if (zl) { z1p[r * PB] = (bf16_t)0; z2p[r * PB] = (bf16_t)0; }
            }
        }
        __syncthreads();
        if (wid < 4) {
            const int dir = wid >> 1, b = wid & 1;
            const LAS bf16_t* a21s = A21s + (dir * 2 + b) * 16 * 40; const LAS bf16_t* t22s = T22s + (dir * 2 + b) * 16 * 40;
            LAS bf16_t* tub = TU + (dir * 2 + b) * 32 * 40; LAS bf16_t* xts = XTs + (dir * 2 + b) * 16 * 40;
            f32x4 x = {0.f, 0.f, 0.f, 0.f};
            x = mfma16(rd_frag(a21s, 40, 0, 0, lane), tr_frag(tub, 40, 0, 0, lane), x);
            *(LAS u32x2*)(xts + (lane & 15) * 40 + 4 * (lane >> 4)) = pack4(x);
            f32x4 y = {0.f, 0.f, 0.f, 0.f};
            y = mfma16(rd_frag(t22s, 40, 0, 0, lane), rd_frag(xts, 40, 0, 0, lane), y);
            const int n = lane & 15, m0 = 4 * (lane >> 4);
            const int jn = sp(32 * b + n, dir); const float bj = bs[dir * 64 + jn], bg = bj * __expf(Gs[dir * 64 + jn]);
#pragma unroll
            for (int r = 0; r < 4; ++r) {
                const int pp = 32 * b + 16 + m0 + r;
                tub[(16 + m0 + r) * 40 + n] = f2bf(-y[r]);
                T1[(dir * 64 + pp) * PB + jn] = f2bf(-y[r] * bj); T2[(dir * 64 + pp) * PB + jn] = f2bf(-y[r] * bg);
            }
        }
        __syncthreads();
        if (wid < 2) {
            const int dir = wid;
            const LAS bf16_t* a21 = A21 + dir * 32 * 40; const LAS bf16_t* tu11 = TU + (dir * 2) * 32 * 40; LAS bf16_t* xt = XT + dir * 32 * 40;
            const LAS bf16_t* tu22 = TU + (dir * 2 + 1) * 32 * 40;
#pragma unroll
            for (int tm = 0; tm < 2; ++tm)
#pragma unroll
                for (int tn = 0; tn < 2; ++tn) {
                    f32x4 x = {0.f, 0.f, 0.f, 0.f};
                    x = mfma16(rd_frag(a21, 40, 16 * tm, 0, lane), tr_frag(tu11, 40, 0, 16 * tn, lane), x);
                    *(LAS u32x2*)(xt + (16 * tn + (lane & 15)) * 40 + 16 * tm + 4 * (lane >> 4)) = pack4(x);
                }
#pragma unroll
            for (int tm = 0; tm < 2; ++tm)
#pragma unroll
                for (int tn = 0; tn < 2; ++tn) {
                    f32x4 y = {0.f, 0.f, 0.f, 0.f};
                    y = mfma16(rd_frag(tu22, 40, 16 * tm, 0, lane), rd_frag(xt, 40, 16 * tn, 0, lane), y);
                    const int jn = sp(16 * tn + (lane & 15), dir); const float bj = bs[dir * 64 + jn], bg = bj * __expf(Gs[dir * 64 + jn]);
                    const int pp0 = 32 + 16 * tm + 4 * (lane >> 4);
#pragma unroll
                    for (int r = 0; r < 4; ++r) { T1[(dir * 64 + pp0 + r) * PB + jn] = f2bf(-y[r] * bj); T2[(dir * 64 + pp0 + r) * PB + jn] = f2bf(-y[r] * bg); }
                }
        }
        __syncthreads();
        {
            const int dir = wid >> 2, sub = wid & 3;
            bf16_t* u0 = U0T + (size_t)(ch * 2 + dir) * 8192; bf16_t* wk = WKg + (size_t)(ch * 2 + dir) * 8192;
            const bf16x8 a0 = rd_frag(T1 + dir * 64 * PB, PB, 16 * sub, 0, lane), a1 = rd_frag(T1 + dir * 64 * PB, PB, 16 * sub, 32, lane);
            const bf16x8 b0 = rd_frag(T2 + dir * 64 * PB, PB, 16 * sub, 0, lane), b1 = rd_frag(T2 + dir * 64 * PB, PB, 16 * sub, 32, lane);
#pragma unroll 2
            for (int tn = 0; tn < 8; ++tn) {
                f32x4 a = {0.f, 0.f, 0.f, 0.f}, b = a;
                a = mfma16(a0, tr_frag(vv, PA, 0, 16 * tn, lane), a); a = mfma16(a1, tr_frag(vv, PA, 32, 16 * tn, lane), a);
                {
                    const int pp0 = 16 * sub + 4 * (lane >> 4);
                    f32x4 ar; ar[0] = a[3]; ar[1] = a[2]; ar[2] = a[1]; ar[3] = a[0];
                    *(u32x2*)(u0 + (16 * tn + (lane & 15)) * 64 + (dir ? 60 - pp0 : pp0)) = pack4(dir ? ar : a);
                }
                b = mfma16(tr_frag(kn, PA, 0, 16 * tn, lane), b0, b); b = mfma16(tr_frag(kn, PA, 32, 16 * tn, lane), b1, b);
                *(u32x2*)(wk + sp(16 * sub + (lane & 15), dir) * 128 + 16 * tn + 4 * (lane >> 4)) = pack4(b);
            }
        }
    }
}

struct SeqInfo { int rowbase, NC, b; bool samp; };
__device__ __forceinline__ SeqInfo seq_info(int seq) { SeqInfo s; s.samp = seq >= 16; s.NC = s.samp ? 64 : 4; s.b = s.samp ? seq - 16 : seq; s.rowbase = s.samp ? 4096 + (seq - 16) * 4096 : seq * 256; return s; }
__device__ __forceinline__ size_t state_index(int b, int l, int dir, int h) { return (size_t)(((b * 2 + l) * 2 + dir) * 8 + h); }

__device__ __forceinline__ void state_load(f32x4 (&acc)[4], const float* src, int eh, LAS bf16_t* ST, const Frame& f) {
    const int d0 = 16 * f.wid + 4 * (f.lane >> 4), e0 = f.lane & 15;
#pragma unroll
    for (int te = 0; te < 4; ++te) {
        f32x4 v = {0.f, 0.f, 0.f, 0.f};
        if (src) {
#pragma unroll
            for (int r = 0; r < 4; ++r) v[r] = src[(size_t)(d0 + r) * 128 + 64 * eh + 16 * te + e0]; }
        acc[te] = v;
        *(LAS u32x2*)(ST + (16 * te + e0) * PA + d0) = pack4(v);
    }
}
__device__ __forceinline__ void state_store(const f32x4 (&acc)[4], float* dst, int eh, const Frame& f) {
    const int d0 = 16 * f.wid + 4 * (f.lane >> 4), e0 = f.lane & 15;
#pragma unroll
    for (int te = 0; te < 4; ++te)
#pragma unroll
        for (int r = 0; r < 4; ++r) dst[(size_t)(d0 + r) * 128 + 64 * eh + 16 * te + e0] = acc[te][r];
}

constexpr int SC_Q = 0, SC_K = 18432, SC_K2 = 36864, SC_V = 55296, SC_P = 65536, SC_ST = 75776, SC_VEC = 94208;

__device__ __forceinline__ void ret_item(const Params& p, int l, int seq, int h, int dir, int eh, unsigned* qnext, const Frame& f) {
    LAS bf16_t* q = (LAS bf16_t*)(f.lds + SC_Q); LAS bf16_t* ke = (LAS bf16_t*)(f.lds + SC_K); LAS bf16_t* vv = (LAS bf16_t*)(f.lds + SC_V);
    LAS bf16_t* P = (LAS bf16_t*)(f.lds + SC_P); LAS bf16_t* ST = (LAS bf16_t*)(f.lds + SC_ST);
    const bf16_t* PQ = (const bf16_t*)(f.ws + WS_PQ); const float* rope = (const float*)(f.ws + WS_ROPE);
    bf16_t* HS = (bf16_t*)(f.ws + WS_HS) + (size_t)(2 * 2 + dir) * MROWS * 1024;
    const SeqInfo si = seq_info(seq);
    const int tid = f.tid, lane = f.lane, wid = f.wid;
    const float lg = p.in[I_LGAM][(l * 2 + dir) * 8 + h];
    const size_t sidx = state_index(si.b, l, dir, h);
    f32x4 accS[4];
    __syncthreads();
    state_load(accS, si.samp ? p.in[I_SR] + sidx * 16384 : nullptr, eh, ST, f);
    const float cdec = __expf(lg * 64.0f);
    const int si_i = tid >> 3, si_s = tid & 7;
    u32x4 rq1, rq2, rk1, rk2, rv; f32x4 rcs[4];
    const int rope_f0 = (si_s < 4) ? 8 * si_s : 8 * si_s - 32;
    {
        const int cn = dir ? si.NC - 1 : 0;
        { const f32x4* cs4 = (const f32x4*)(rope + (size_t)(((si_s < 4) ? cn : si_i) * 32 + rope_f0) * 2); rcs[0] = cs4[0]; rcs[1] = cs4[1]; rcs[2] = cs4[2]; rcs[3] = cs4[3]; }
        const bf16_t* src = PQ + (size_t)(si.rowbase + 64 * cn + si_i) * LDQ + h * 128 + 8 * si_s;
        rq1 = *(const u32x4*)(src + 6144); rq2 = *(const u32x4*)(src + 6144 + 64); rk1 = *(const u32x4*)(src + 7168); rk2 = *(const u32x4*)(src + 7168 + 64);
        rv = *(const u32x4*)(src + 8192 + 64 * eh);
    }
    int nxt = 0;
#pragma unroll 1
    for (int n = 0; n < si.NC; ++n) {
        if (n == si.NC - 1 && f.tid == 0) nxt = (int)__hip_atomic_fetch_add(qnext, 1u, __ATOMIC_RELAXED, __HIP_MEMORY_SCOPE_AGENT);
        const int cn = dir ? si.NC - 1 - n : n, row0 = si.rowbase + 64 * cn;
        {
            const int i = si_i, s = si_s;
            float q1[8], q2[8], k1[8], k2[8];
            unpack8(rq1, q1); unpack8(rq2, q2); unpack8(rk1, k1); unpack8(rk2, k2);
            const float kes = __expf(lg * (float)(63 - sp(i, dir)));
            if (si.samp) {
#pragma unroll
                for (int j = 0; j < 8; ++j) { const float c = rcs[j >> 1][2 * (j & 1)], sn = rcs[j >> 1][2 * (j & 1) + 1];
                    const float a = q1[j] * c - q2[j] * sn, b = q2[j] * c + q1[j] * sn; q1[j] = a; q2[j] = b;
                    const float a2 = k1[j] * c - k2[j] * sn, b2 = k2[j] * c + k1[j] * sn; k1[j] = a2; k2[j] = b2; }
            }
#pragma unroll
            for (int j = 0; j < 8; ++j) { q1[j] *= QSCALE; q2[j] *= QSCALE; k1[j] *= kes; k2[j] *= kes; }
            *(LAS u32x4*)(q + i * PA + 8 * s) = pack8(q1); *(LAS u32x4*)(q + i * PA + 64 + 8 * s) = pack8(q2);
            *(LAS u32x4*)(ke + i * PA + 8 * s) = pack8(k1); *(LAS u32x4*)(ke + i * PA + 64 + 8 * s) = pack8(k2);
            *(LAS u32x4*)(vv + i * PB + 8 * s) = rv;
        }
        if (n + 1 < si.NC) {
            const int cn2 = dir ? si.NC - 2 - n : n + 1;
            { const f32x4* cs4 = (const f32x4*)(rope + (size_t)(((si_s < 4) ? cn2 : si_i) * 32 + rope_f0) * 2); rcs[0] = cs4[0]; rcs[1] = cs4[1]; rcs[2] = cs4[2]; rcs[3] = cs4[3]; }
            const bf16_t* src = PQ + (size_t)(si.rowbase + 64 * cn2 + si_i) * LDQ + h * 128 + 8 * si_s;
            rq1 = *(const u32x4*)(src + 6144); rq2 = *(const u32x4*)(src + 6144 + 64); rk1 = *(const u32x4*)(src + 7168); rk2 = *(const u32x4*)(src + 7168 + 64);
            rv = *(const u32x4*)(src + 8192 + 64 * eh);
        }
        __syncthreads();
#pragma unroll
        for (int t2 = 0; t2 < 2; ++t2) {
            const int tt = 2 * wid + t2, tm = tt >> 2, tn = tt & 3;
            f32x4 a = {0.f, 0.f, 0.f, 0.f};
#pragma unroll
            for (int ks = 0; ks < 4; ++ks) a = mfma16(rd_frag(ke, PA, 16 * tm, 32 * ks, lane), rd_frag(q, PA, 16 * tn, 32 * ks, lane), a);
            const int j0 = 16 * tm + 4 * (lane >> 4), i = 16 * tn + (lane & 15), pi = sp(i, dir);
            const float rsc = __expf(lg * (float)(pi - 63));
            f32x4 v;
#pragma unroll
            for (int r = 0; r < 4; ++r) v[r] = (sp(j0 + r, dir) <= pi) ? a[r] * rsc : 0.f;
            *(LAS u32x2*)(P + i * PB + j0) = pack4(v);
        }
        const int te = wid >> 1, ti0 = 2 * (wid & 1);
        f32x4 accO[2] = {{0.f, 0.f, 0.f, 0.f}, {0.f, 0.f, 0.f, 0.f}};
#pragma unroll
        for (int ks = 0; ks < 4; ++ks) {
            const bf16x8 a = rd_frag(ST, PA, 16 * te, 32 * ks, lane);
            accO[0] = mfma16(a, rd_frag(q, PA, 16 * ti0, 32 * ks, lane), accO[0]);
            accO[1] = mfma16(a, rd_frag(q, PA, 16 * ti0 + 16, 32 * ks, lane), accO[1]);
        }
        accO[0] *= __expf(lg * (float)(sp(16 * ti0 + (lane & 15), dir) + 1));
        accO[1] *= __expf(lg * (float)(sp(16 * ti0 + 16 + (lane & 15), dir) + 1));
        __syncthreads();
#pragma unroll
        for (int ks = 0; ks < 2; ++ks) {
            const bf16x8 a = tr_frag(vv, PB, 32 * ks, 16 * te, lane);
            accO[0] = mfma16(a, rd_frag(P, PB, 16 * ti0, 32 * ks, lane), accO[0]);
            accO[1] = mfma16(a, rd_frag(P, PB, 16 * ti0 + 16, 32 * ks, lane), accO[1]);
        }
#pragma unroll
        for (int t = 0; t < 2; ++t)
            *(u32x2*)(HS + (size_t)(row0 + 16 * (ti0 + t) + (lane & 15)) * 1024 + h * 128 + 64 * eh + 16 * te + 4 * (lane >> 4)) = pack4(accO[t]);
        {
            const bf16x8 a0 = tr_frag(ke, PA, 0, 16 * wid, lane), a1 = tr_frag(ke, PA, 32, 16 * wid, lane);
#pragma unroll
            for (int t = 0; t < 4; ++t) {
                accS[t] = mfma16(a0, tr_frag(vv, PB, 0, 16 * t, lane), accS[t] * cdec);
                accS[t] = mfma16(a1, tr_frag(vv, PB, 32, 16 * t, lane), accS[t]);
                *(LAS u32x2*)(ST + (16 * t + (lane & 15)) * PA + 16 * wid + 4 * (lane >> 4)) = pack4(accS[t]);
            }
        }
        __syncthreads();
    }
    if (!si.samp) state_store(accS, f.out + OUT_RS + sidx * 16384, eh, f);
    if (f.tid == 0) *(volatile LAS int*)(f.lds + LDS_BYTES - 128) = nxt;
}

__device__ __forceinline__ void mlstm_item(const Params& p, int l, int seq, int h, int dir, int eh, unsigned* qnext, const Frame& f) {
    LAS bf16_t* q = (LAS bf16_t*)(f.lds + SC_Q); LAS bf16_t* k = (LAS bf16_t*)(f.lds + SC_K); LAS bf16_t* kw = (LAS bf16_t*)(f.lds + SC_K2);
    LAS bf16_t* vv = (LAS bf16_t*)(f.lds + SC_V); LAS bf16_t* P = (LAS bf16_t*)(f.lds + SC_P); LAS bf16_t* CT = (LAS bf16_t*)(f.lds + SC_ST);
    LAS float* vec = (LAS float*)(f.lds + SC_VEC);
    LAS float* va = vec, *vr = vec + 64, *vwp = vec + 128, *vem = vec + 192, *vwt = vec + 256, *vqn = vec + 320, *vdd = vec + 384, *nvec = vec + 448, *scv = vec + 576;
    const bf16_t* PQ = (const bf16_t*)(f.ws + WS_PQ); const float* GT = (const float*)(f.ws + WS_GT);
    bf16_t* HS = (bf16_t*)(f.ws + WS_HS) + (size_t)(0 * 2 + dir) * MROWS * 1024;
    const SeqInfo si = seq_info(seq);
    const int tid = f.tid, lane = f.lane, wid = f.wid;
    const float fbias = p.in[I_FBIAS][(l * 2 + dir) * 8 + h];
    const size_t sidx = state_index(si.b, l, dir, h);
    f32x4 accC[4], accN;
    __syncthreads();
    state_load(accC, si.samp ? p.in[I_SC] + sidx * 16384 : nullptr, eh, CT, f);
    {
        const int d0 = 16 * wid + 4 * (lane >> 4);
#pragma unroll
        for (int r = 0; r < 4; ++r) accN[r] = si.samp ? p.in[I_SN][sidx * 128 + d0 + r] : 0.f;
        if ((lane & 15) == 0) {
#pragma unroll
            for (int r = 0; r < 4; ++r) nvec[d0 + r] = accN[r]; }
    }
    float m_prev = si.samp ? p.in[I_SM][sidx] : 0.f;
    const int si_i = tid >> 3, si_s = tid & 7;
    u32x4 rq1, rq2, rk1, rk2, rv; float rig = 0.f, rfp = 0.f;
    {
        const int cn = dir ? si.NC - 1 : 0, row0 = si.rowbase + 64 * cn;
        const bf16_t* src = PQ + (size_t)(row0 + si_i) * LDQ + h * 128 + 8 * si_s;
        rq1 = *(const u32x4*)(src); rq2 = *(const u32x4*)(src + 64); rk1 = *(const u32x4*)(src + 1024); rk2 = *(const u32x4*)(src + 1024 + 64);
        rv = *(const u32x4*)(src + 2048 + 64 * eh);
        if (wid == 0) { const size_t row = (size_t)(row0 + sp(lane, dir)); rig = GT[row * 64 + dir * 8 + h]; rfp = GT[row * 64 + 16 + dir * 8 + h]; }
    }
    bf16x8 ones;
#pragma unroll
    for (int j = 0; j < 8; ++j) ones[j] = (short)0x3F80;
    int nxt = 0;
#pragma unroll 1
    for (int n = 0; n < si.NC; ++n) {
        if (n == si.NC - 1 && f.tid == 0) nxt = (int)__hip_atomic_fetch_add(qnext, 1u, __ATOMIC_RELAXED, __HIP_MEMORY_SCOPE_AGENT);
        const int cn = dir ? si.NC - 1 - n : n, row0 = si.rowbase + 64 * cn;
#pragma unroll 1
        for (int rep = 0; rep < ((PROBE_SEG == 4) ? 2 : 1); ++rep)
        if (wid == 0) {
            const int i = sp(lane, dir);
            const float ig = rig, fp = rfp + fbias;
            const float lf = fminf(fp, 0.f) - __logf(1.0f + __expf(-fabsf(fp)));
            const float b = wave_scan_add(lf, lane), a = ig - b, pm = wave_scan_max(a, lane);
            const float bL = __shfl(b, 63), pmL = __shfl(pm, 63);
            const float mx = fmaxf(m_prev, pm);
            va[i] = a; vr[i] = -mx; vwp[i] = __expf(m_prev - mx); vem[i] = __expf(-(b + mx));
            const float m_new = bL + fmaxf(m_prev, pmL);
            vwt[i] = __expf(bL + a - m_new);
            if (lane == 0) { scv[0] = __expf(bL + m_prev - m_new); scv[1] = m_new; }
        }
#pragma unroll 1
        for (int rep = 0; rep < ((PROBE_SEG == 3) ? 2 : 1); ++rep)
        {
            const int i = si_i, s = si_s;
            float k1[8], k2[8];
            unpack8(rk1, k1); unpack8(rk2, k2);
#pragma unroll
            for (int j = 0; j < 8; ++j) { k1[j] *= QSCALE; k2[j] *= QSCALE; }
            *(LAS u32x4*)(q + i * PA + 8 * s) = rq1; *(LAS u32x4*)(q + i * PA + 64 + 8 * s) = rq2;
            *(LAS u32x4*)(k + i * PA + 8 * s) = pack8(k1); *(LAS u32x4*)(k + i * PA + 64 + 8 * s) = pack8(k2);
            *(LAS u32x4*)(vv + i * PB + 8 * s) = rv;
        }
        if (n + 1 < si.NC) {
            const int cn2 = dir ? si.NC - 2 - n : n + 1, row2 = si.rowbase + 64 * cn2;
            const bf16_t* src = PQ + (size_t)(row2 + si_i) * LDQ + h * 128 + 8 * si_s;
            rq1 = *(const u32x4*)(src); rq2 = *(const u32x4*)(src + 64); rk1 = *(const u32x4*)(src + 1024); rk2 = *(const u32x4*)(src + 1024 + 64);
            rv = *(const u32x4*)(src + 2048 + 64 * eh);
            if (wid == 0) { const size_t row = (size_t)(row2 + sp(lane, dir)); rig = GT[row * 64 + dir * 8 + h]; rfp = GT[row * 64 + 16 + dir * 8 + h]; }
        }
        __syncthreads();
#pragma unroll 1
        for (int rep = 0; rep < ((PROBE_SEG == 1) ? 2 : 1); ++rep)
#pragma unroll
        for (int t2 = 0; t2 < 2; ++t2) {
            const int tt = 2 * wid + t2, tm = tt >> 2, tn = tt & 3;
            f32x4 a = {0.f, 0.f, 0.f, 0.f};
#pragma unroll
            for (int ks = 0; ks < 4; ++ks) a = mfma16(rd_frag(k, PA, 16 * tm, 32 * ks, lane), rd_frag(q, PA, 16 * tn, 32 * ks, lane), a);
            const int j0 = 16 * tm + 4 * (lane >> 4), i = 16 * tn + (lane & 15), pi = sp(i, dir);
            const float ri = vr[i];
            f32x4 v;
#pragma unroll
            for (int r = 0; r < 4; ++r) { const float e = a[r] * __expf(fminf(va[j0 + r] + ri, 0.f)); v[r] = (sp(j0 + r, dir) <= pi) ? e : 0.f; }
            *(LAS u32x2*)(P + i * PB + j0) = pack4(v);
        }
        const int te = wid >> 1, ti0 = 2 * (wid & 1);
        f32x4 accO[2] = {{0.f, 0.f, 0.f, 0.f}, {0.f, 0.f, 0.f, 0.f}};
#pragma unroll 1
        for (int rep = 0; rep < ((PROBE_SEG == 2) ? 2 : 1); ++rep) { accO[0] = (f32x4){0.f, 0.f, 0.f, 0.f}; accO[1] = accO[0]; asm volatile("" : "+v"(accO[0]), "+v"(accO[1]));
#pragma unroll
        for (int ks = 0; ks < 4; ++ks) {
            const bf16x8 a = rd_frag(CT, PA, 16 * te, 32 * ks, lane);
            accO[0] = mfma16(a, rd_frag(q, PA, 16 * ti0, 32 * ks, lane), accO[0]);
            accO[1] = mfma16(a, rd_frag(q, PA, 16 * ti0 + 16, 32 * ks, lane), accO[1]);
        }
        }
        accO[0] *= vwp[16 * ti0 + (lane & 15)];
        accO[1] *= vwp[16 * ti0 + 16 + (lane & 15)];
        {
            const int i = tid >> 3, s = tid & 7; float sum = 0.f;
            float x0[8], x1[8];
            unpack8(*(const LAS u32x4*)(q + i * PA + 16 * s), x0); unpack8(*(const LAS u32x4*)(q + i * PA + 16 * s + 8), x1);
#pragma unroll
            for (int c = 0; c < 8; ++c) sum += x0[c] * nvec[16 * s + c] + x1[c] * nvec[16 * s + 8 + c];
            sum += __shfl_xor(sum, 1); sum += __shfl_xor(sum, 2); sum += __shfl_xor(sum, 4);
            if (s == 0) vqn[i] = sum;
        }
        __syncthreads();
#pragma unroll
        for (int ks = 0; ks < 2; ++ks) {
            const bf16x8 a = tr_frag(vv, PB, 32 * ks, 16 * te, lane);
            accO[0] = mfma16(a, rd_frag(P, PB, 16 * ti0, 32 * ks, lane), accO[0]);
            accO[1] = mfma16(a, rd_frag(P, PB, 16 * ti0 + 16, 32 * ks, lane), accO[1]);
        }
        {
            const int i = tid >> 3, s = tid & 7; float x0[8];
            unpack8(*(const LAS u32x4*)(P + i * PB + 8 * s), x0);
            float sum = ((x0[0] + x0[1]) + (x0[2] + x0[3])) + ((x0[4] + x0[5]) + (x0[6] + x0[7]));
            sum += __shfl_xor(sum, 1); sum += __shfl_xor(sum, 2); sum += __shfl_xor(sum, 4);
            if (s == 0) { const float den = vwp[i] * vqn[i] + sum; vdd[i] = fmaxf(fabsf(den), vem[i]); }
        }
        const float ws = scv[0];
        {
            bf16x8 a0 = tr_frag(k, PA, 0, 16 * wid, lane), a1 = tr_frag(k, PA, 32, 16 * wid, lane);
            {
                const int j0 = 8 * (lane >> 4);
                const f32x4 wa = *(const LAS f32x4*)(vwt + j0), wb = *(const LAS f32x4*)(vwt + j0 + 4), wc2 = *(const LAS f32x4*)(vwt + 32 + j0), wd = *(const LAS f32x4*)(vwt + 32 + j0 + 4);
                u32x4 u0 = __builtin_bit_cast(u32x4, a0), u1 = __builtin_bit_cast(u32x4, a1);
                u0.x = cvt_pk_bf16(bflo(u0.x) * wa[0], bfhi(u0.x) * wa[1]); u0.y = cvt_pk_bf16(bflo(u0.y) * wa[2], bfhi(u0.y) * wa[3]);
                u0.z = cvt_pk_bf16(bflo(u0.z) * wb[0], bfhi(u0.z) * wb[1]); u0.w = cvt_pk_bf16(bflo(u0.w) * wb[2], bfhi(u0.w) * wb[3]);
                u1.x = cvt_pk_bf16(bflo(u1.x) * wc2[0], bfhi(u1.x) * wc2[1]); u1.y = cvt_pk_bf16(bflo(u1.y) * wc2[2], bfhi(u1.y) * wc2[3]);
                u1.z = cvt_pk_bf16(bflo(u1.z) * wd[0], bfhi(u1.z) * wd[1]); u1.w = cvt_pk_bf16(bflo(u1.w) * wd[2], bfhi(u1.w) * wd[3]);
                a0 = __builtin_bit_cast(bf16x8, u0); a1 = __builtin_bit_cast(bf16x8, u1);
            }
            accN = mfma16(a0, ones, accN * ws); accN = mfma16(a1, ones, accN);
#pragma unroll
            for (int t = 0; t < 4; ++t) {
                accC[t] = mfma16(a0, tr_frag(vv, PB, 0, 16 * t, lane), accC[t] * ws);
                accC[t] = mfma16(a1, tr_frag(vv, PB, 32, 16 * t, lane), accC[t]);
            }
        }
        m_prev = scv[1];
        __syncthreads();
#pragma unroll
        for (int t = 0; t < 2; ++t) {
            const int i = 16 * (ti0 + t) + (lane & 15);
            const float inv = 1.0f / vdd[i];
            *(u32x2*)(HS + (size_t)(row0 + i) * 1024 + h * 128 + 64 * eh + 16 * te + 4 * (lane >> 4)) = pack4(accO[t] * inv);
        }
#pragma unroll
        for (int t = 0; t < 4; ++t) *(LAS u32x2*)(CT + (16 * t + (lane & 15)) * PA + 16 * wid + 4 * (lane >> 4)) = pack4(accC[t]);
        if ((lane & 15) == 0) {
#pragma unroll
            for (int r = 0; r < 4; ++r) nvec[16 * wid + 4 * (lane >> 4) + r] = accN[r]; }
    }
    if (!si.samp) {
        state_store(accC, f.out + OUT_C + sidx * 16384, eh, f);
        if (eh == 0) {
            if ((lane & 15) == 0) {
#pragma unroll
                for (int r = 0; r < 4; ++r) f.out[OUT_N + sidx * 128 + 16 * wid + 4 * (lane >> 4) + r] = accN[r]; }
            if (tid == 0) f.out[OUT_M + sidx] = m_prev;
        }
    }
    if (f.tid == 0) *(volatile LAS int*)(f.lds + LDS_BYTES - 128) = nxt;
}

__device__ __forceinline__ void delta_item(const Params& p, int l, int seq, int h, int dir, int eh, unsigned* qnext, const Frame& f) {
    LAS bf16_t* q = (LAS bf16_t*)(f.lds + SC_Q); LAS bf16_t* Wk = (LAS bf16_t*)(f.lds + SC_K);
    LAS bf16_t* UT = (LAS bf16_t*)(f.lds + SC_V); LAS bf16_t* ST = (LAS bf16_t*)(f.lds + SC_ST);
    constexpr int SC_KE2 = 96768, SC_QK2 = 115200;
    LAS float* veg = (LAS float*)(f.lds + SC_VEC);
    const bf16_t* QN = (const bf16_t*)(f.ws + WS_QN); const bf16_t* KNg = (const bf16_t*)(f.ws + WS_KT); const bf16_t* U0T = (const bf16_t*)(f.ws + WS_U0T);
    const bf16_t* WKg = (const bf16_t*)(f.ws + WS_WK); const bf16_t* QKD = (const bf16_t*)(f.ws + WS_QKD); const float* GCH = (const float*)(f.ws + WS_GCH);
    bf16_t* HS = (bf16_t*)(f.ws + WS_HS) + (size_t)(1 * 2 + dir) * MROWS * 1024;
    const SeqInfo si = seq_info(seq);
    const int tid = f.tid, lane = f.lane, wid = f.wid;
    const size_t sidx = state_index(si.b, l, dir, h);
    f32x4 accS[4];
    __syncthreads();
    state_load(accS, si.samp ? p.in[I_SD] + sidx * 16384 : nullptr, eh, ST, f);
    const int si_i = tid >> 3, si_s = tid & 7;
    const int ti_u = wid >> 1, te_u0 = 2 * (wid & 1);
    u32x4 rq1, rq2, rw1, rw2, rk1, rk2, rqk; u32x2 ru0, ru1; float rG = 0.f, rGl = 0.f;
    {
        const int cn = dir ? si.NC - 1 : 0, row0 = si.rowbase + 64 * cn, chd = ((row0 >> 6) * 8 + h) * 2 + dir;
        const bf16_t* sq = QN + (size_t)(row0 + si_i) * 1024 + h * 128 + 16 * si_s; rq1 = *(const u32x4*)sq; rq2 = *(const u32x4*)(sq + 8);
        const bf16_t* sk = KNg + (size_t)(row0 + si_i) * 1024 + h * 128 + 16 * si_s; rk1 = *(const u32x4*)sk; rk2 = *(const u32x4*)(sk + 8);
        const bf16_t* sw = WKg + (size_t)chd * 8192 + si_i * 128 + 16 * si_s; rw1 = *(const u32x4*)sw; rw2 = *(const u32x4*)(sw + 8);
        rqk = *(const u32x4*)(QKD + (size_t)chd * 4096 + si_i * 64 + 8 * si_s);
        const bf16_t* su = U0T + (size_t)chd * 8192 + (size_t)(64 * eh + 16 * te_u0 + (lane & 15)) * 64 + 16 * ti_u + 4 * (lane >> 4);
        ru0 = *(const u32x2*)su; ru1 = *(const u32x2*)(su + 16 * 64);
        rG = GCH[(size_t)chd * 64 + si_i]; rGl = GCH[(size_t)chd * 64 + (dir ? 0 : 63)];
    }
    int nxt = 0;
#pragma unroll 1
    for (int n = 0; n < si.NC; ++n) {
        if (n == si.NC - 1 && f.tid == 0) nxt = (int)__hip_atomic_fetch_add(qnext, 1u, __ATOMIC_RELAXED, __HIP_MEMORY_SCOPE_AGENT);
        const int cn = dir ? si.NC - 1 - n : n, row0 = si.rowbase + 64 * cn;
        const float Glast = rGl;
        const u32x2 cu0 = ru0, cu1 = ru1;
        LAS bf16_t* ke = (LAS bf16_t*)(f.lds + SC_K2); LAS bf16_t* QKd = (LAS bf16_t*)(f.lds + SC_P);
#pragma unroll 1
        for (int rep = 0; rep < ((PROBE_SEG == 6) ? 2 : 1); ++rep)
        {
            const int i = si_i, s = si_s;
            *(LAS u32x4*)(q + i * PA + 16 * s) = rq1; *(LAS u32x4*)(q + i * PA + 16 * s + 8) = rq2;
            *(LAS u32x4*)(Wk + i * PA + 16 * s) = rw1; *(LAS u32x4*)(Wk + i * PA + 16 * s + 8) = rw2;
            *(LAS u32x4*)(QKd + i * PB + 8 * s) = rqk;
            float x0[8], x1[8];
            unpack8(rk1, x0); unpack8(rk2, x1);
            const float ksc = __expf(Glast - rG);
#pragma unroll
            for (int j = 0; j < 8; ++j) { x0[j] *= ksc; x1[j] *= ksc; }
            *(LAS u32x4*)(ke + i * PA + 16 * s) = pack8(x0); *(LAS u32x4*)(ke + i * PA + 16 * s + 8) = pack8(x1);
            if (s == 0) veg[i] = __expf(rG);
        }
        if (n + 1 < si.NC) {
            const int cn2 = dir ? si.NC - 2 - n : n + 1, row2 = si.rowbase + 64 * cn2, chd = ((row2 >> 6) * 8 + h) * 2 + dir;
            const bf16_t* sq = QN + (size_t)(row2 + si_i) * 1024 + h * 128 + 16 * si_s; rq1 = *(const u32x4*)sq; rq2 = *(const u32x4*)(sq + 8);
            const bf16_t* sk = KNg + (size_t)(row2 + si_i) * 1024 + h * 128 + 16 * si_s; rk1 = *(const u32x4*)sk; rk2 = *(const u32x4*)(sk + 8);
            const bf16_t* sw = WKg + (size_t)chd * 8192 + si_i * 128 + 16 * si_s; rw1 = *(const u32x4*)sw; rw2 = *(const u32x4*)(sw + 8);
            rqk = *(const u32x4*)(QKD + (size_t)chd * 4096 + si_i * 64 + 8 * si_s);
            const bf16_t* su = U0T + (size_t)chd * 8192 + (size_t)(64 * eh + 16 * te_u0 + (lane & 15)) * 64 + 16 * ti_u + 4 * (lane >> 4);
            ru0 = *(const u32x2*)su; ru1 = *(const u32x2*)(su + 16 * 64);
            rG = GCH[(size_t)chd * 64 + si_i]; rGl = GCH[(size_t)chd * 64 + (dir ? 0 : 63)];
        }
        __syncthreads();
#pragma unroll 1
        for (int rep = 0; rep < ((PROBE_SEG == 5) ? 2 : 1); ++rep)
        {
            f32x4 a0 = {0.f, 0.f, 0.f, 0.f}, a1 = a0;
#pragma unroll
            for (int ks = 0; ks < 4; ++ks) {
                const bf16x8 a = rd_frag(Wk, PA, 16 * ti_u, 32 * ks, lane);
                a0 = mfma16(a, rd_frag(ST, PA, 16 * te_u0, 32 * ks, lane), a0);
                a1 = mfma16(a, rd_frag(ST, PA, 16 * te_u0 + 16, 32 * ks, lane), a1);
            }
            const int i0 = 16 * ti_u + 4 * (lane >> 4);
            f32x4 u; u[0] = bflo(cu0.x) - a0[0]; u[1] = bfhi(cu0.x) - a0[1]; u[2] = bflo(cu0.y) - a0[2]; u[3] = bfhi(cu0.y) - a0[3];
            *(LAS u32x2*)(UT + (16 * te_u0 + (lane & 15)) * PB + i0) = pack4(u);
            u[0] = bflo(cu1.x) - a1[0]; u[1] = bfhi(cu1.x) - a1[1]; u[2] = bflo(cu1.y) - a1[2]; u[3] = bfhi(cu1.y) - a1[3];
            *(LAS u32x2*)(UT + (16 * te_u0 + 16 + (lane & 15)) * PB + i0) = pack4(u);
        }
        const int te = wid >> 1, ti0 = 2 * (wid & 1);
        f32x4 accO[2] = {{0.f, 0.f, 0.f, 0.f}, {0.f, 0.f, 0.f, 0.f}};
#pragma unroll
        for (int ks = 0; ks < 4; ++ks) {
            const bf16x8 a = rd_frag(ST, PA, 16 * te, 32 * ks, lane);
            accO[0] = mfma16(a, rd_frag(q, PA, 16 * ti0, 32 * ks, lane), accO[0]);
            accO[1] = mfma16(a, rd_frag(q, PA, 16 * ti0 + 16, 32 * ks, lane), accO[1]);
        }
        accO[0] *= veg[16 * ti0 + (lane & 15)];
        accO[1] *= veg[16 * ti0 + 16 + (lane & 15)];
        __syncthreads();
#pragma unroll
        for (int ks = 0; ks < 2; ++ks) {
            const bf16x8 a = rd_frag(UT, PB, 16 * te, 32 * ks, lane);
            accO[0] = mfma16(a, rd_frag(QKd, PB, 16 * ti0, 32 * ks, lane), accO[0]);
            accO[1] = mfma16(a, rd_frag(QKd, PB, 16 * ti0 + 16, 32 * ks, lane), accO[1]);
        }
#pragma unroll
        for (int t = 0; t < 2; ++t)
            *(u32x2*)(HS + (size_t)(row0 + 16 * (ti0 + t) + (lane & 15)) * 1024 + h * 128 + 64 * eh + 16 * te + 4 * (lane >> 4)) = pack4(accO[t]);
        {
            const float cd = __expf(Glast);
            const bf16x8 a0 = tr_frag(ke, PA, 0, 16 * wid, lane), a1 = tr_frag(ke, PA, 32, 16 * wid, lane);
#pragma unroll
            for (int t = 0; t < 4; ++t) {
                accS[t] = mfma16(a0, rd_frag(UT, PB, 16 * t, 0, lane), accS[t] * cd);
                accS[t] = mfma16(a1, rd_frag(UT, PB, 16 * t, 32, lane), accS[t]);
                *(LAS u32x2*)(ST + (16 * t + (lane & 15)) * PA + 16 * wid + 4 * (lane >> 4)) = pack4(accS[t]);
            }
        }
        __syncthreads();
    }
    if (!si.samp) state_store(accS, f.out + OUT_DS + sidx * 16384, eh, f);
    if (f.tid == 0) *(volatile LAS int*)(f.lds + LDS_BYTES - 128) = nxt;
}

__device__ __forceinline__ int scan_dequeue(unsigned* q, const Frame& f) {
    volatile LAS int* slot = (volatile LAS int*)(f.lds + LDS_BYTES - 128);
    __syncthreads();
    if (f.tid == 0) *slot = (int)__hip_atomic_fetch_add(q, 1u, __ATOMIC_RELAXED, __HIP_MEMORY_SCOPE_AGENT);
    __syncthreads();
    return *slot;
}
__device__ __forceinline__ bool scan_decode(int g, int& seq, int& h, int& dir, int& eh) {
    if (g >= 576) return false;
    if (g < 64) { seq = 16 + (g >> 5); h = (g >> 2) & 7; dir = (g >> 1) & 1; eh = g & 1; return true; }
    const int idx = g - 64; seq = idx >> 5; h = (idx >> 2) & 7; dir = (idx >> 1) & 1; eh = idx & 1; return true;
}
__device__ __forceinline__ void phase_scan(const Params& p, int l, const Frame& f, int mask = 7) {
    unsigned* q = (unsigned*)(f.ws + WS_QUEUE) + (size_t)l * 3 * 64;
    const int start = (f.bid < 64 || f.bid >= 192) ? 0 : (f.bid < 128 ? 1 : 2);
    const bool stat = (f.G == 256) && (mask == 7);
    volatile LAS int* slot = (volatile LAS int*)(f.lds + LDS_BYTES - 128);
    int seq, h, dir, eh;
#pragma unroll 1
    for (int r = 0; r < 3; ++r) {
        const int X = (start + r) % 3;
        if (!((mask >> X) & 1)) continue;
        const int base = stat ? (X == 0 ? 128 : 64) : 0;
        int g = (stat && r == 0) ? (f.bid < 64 ? f.bid : (f.bid >= 192 ? f.bid - 128 : (f.bid & 63))) : scan_dequeue(q + 64 * X, f) + base;
#pragma unroll 1
        for (;;) {
            if (!scan_decode(g, seq, h, dir, eh)) break;
            Frame fi = f; { int t = f.tid; asm volatile("" : "+v"(t)); fi.tid = t; fi.lane = t & 63; }
            if (X == 0) mlstm_item(p, l, seq, h, dir, eh, q + 64 * X, fi);
            else if (X == 1) delta_item(p, l, seq, h, dir, eh, q + 64 * X, fi);
            else ret_item(p, l, seq, h, dir, eh, q + 64 * X, fi);
            __syncthreads();
            g = *slot + base;
        }
    }
}

template <class Epi> __device__ __forceinline__ void run_gemm(const bf16_t* A, const bf16_t* Bt, int N, int K, const Epi& E, const Frame& f) {
    pg8::Gemm g{A, Bt, MROWS, N, K};
    pg8::StaticOrder S; S.init(MROWS, N, f.G, f.bid, N > 8192 ? WGM_WIN : (N == 8192 ? WGM_UP : WGM_N2K));
    pg8::gemm_phase<Epi, pg8::StaticOrder, true, true>(f.lds, g, S, E);
}
__device__ __forceinline__ void phase_ffn_up(const Params& p, int l, int j, const Frame& f) {
    pg8::EpiSwiglu E{(bf16_t*)(f.ws + WS_HID), 4096, (const float*)(f.ws + WS_SS) + (size_t)(l * 3 + (j == 0 ? 0 : 2)) * MROWS,
                     (const float*)(f.ws + WS_SHW) + (size_t)l * SHW_LAYER + (j == 0 ? 0 : SHW_UP1)};
    run_gemm((const bf16_t*)(f.ws + (j == 0 ? WS_H : WS_XB3)), (const bf16_t*)(f.ws + wofs(l) + WS_W13T) + (size_t)j * 8192 * 2048, 8192, 2048, E, f);
}
template <int j> __device__ __forceinline__ void phase_ffn_down(const Params& p, int l, const Frame& f) {
    const float* ada_l = (const float*)(f.ws + WS_ADA) + (size_t)l * 3 * 18432;
    const bool lastl = (j == 1 && l == 1);
    const int nl = lastl ? 1 : ((j == 0) ? l : l + 1), nw = (j == 0) ? 1 : 0;
    const bool firstres = (j == 0 && l == 0);
    pg8::EpiResid<(j == 0 ? 2 : 8), true> E{f.out + OUT_Y, ada_l, firstres ? p.in[I_XP] : f.out + OUT_Y, firstres ? p.in[I_XS] - (size_t)4096 * 2048 : f.out + OUT_Y,
                    (bf16_t*)(f.ws + WS_H), p.in[I_NORMG] + (size_t)(nl * 3 + nw) * 2048,
                    (const float*)(f.ws + WS_ADA) + (size_t)nl * 3 * 18432 + (size_t)(3 * nw + 1) * 2048,
                    (float*)(f.ws + WS_SS) + (size_t)(lastl ? 6 : nl * 3 + nw) * MROWS, lastl ? 0 : 1};
    run_gemm((const bf16_t*)(f.ws + WS_HID), (const bf16_t*)(f.ws + wofs(l) + WS_W2T) + (size_t)j * 2048 * 4096, 2048, 4096, E, f);
    convert_fill(p, l, j == 0 ? 0 : 5, f);
}
__device__ __forceinline__ void phase_win(const Params& p, int l, const Frame& f) {
    pg8::EpiWin E{(bf16_t*)(f.ws + WS_PQ), (bf16_t*)(f.ws + WS_PG), (float*)(f.ws + WS_GT), (const float*)(f.ws + (l ? WS_BIASP1 : WS_BIASP)),
                  (const float*)(f.ws + WS_SS) + (size_t)(l * 3 + 1) * MROWS, (const float*)(f.ws + WS_SHW) + (size_t)l * SHW_LAYER + SHW_WIN};
    run_gemm((const bf16_t*)(f.ws + WS_H), (const bf16_t*)(f.ws + wofs(l) + WS_WINT), NINP, 2048, E, f);
    convert_fill(p, l, 6, f);
}
__device__ __forceinline__ void phase_br(const Params& p, int l, const Frame& f) {
#pragma unroll 1
    for (int seg = 0; seg < 3; ++seg) {
        pg8::EpiBr E{(const bf16_t*)(f.ws + WS_PG), (float*)(f.ws + WS_TMP), (bf16_t*)(f.ws + WS_H), seg};
        run_gemm((const bf16_t*)(f.ws + WS_YS) + (size_t)seg * MROWS * 1024, (const bf16_t*)(f.ws + wofs(l) + WS_WBRT) + (size_t)seg * 2048 * 1024, 2048, 1024, E, f);
        convert_fill(p, l, 1 + seg, f);
        asm volatile("s_waitcnt vmcnt(0)" ::: "memory");
        __syncthreads();
    }
}
__device__ __forceinline__ void phase_wout(const Params& p, int l, const Frame& f) {
    const float* ada_l = (const float*)(f.ws + WS_ADA) + (size_t)l * 3 * 18432;
    pg8::EpiResid<5, false> E{f.out + OUT_Y, ada_l, f.out + OUT_Y, f.out + OUT_Y, (bf16_t*)(f.ws + WS_XB3), p.in[I_NORMG] + (size_t)(l * 3 + 2) * 2048, ada_l + (size_t)7 * 2048, (float*)(f.ws + WS_SS) + (size_t)(l * 3 + 2) * MROWS, 1};
    run_gemm((const bf16_t*)(f.ws + WS_H), (const bf16_t*)(f.ws + wofs(l) + WS_WOUTT), 2048, 2048, E, f);
    convert_fill(p, l, 4, f);
}

constexpr int N_PHASES = 14;
template <int PH> __device__ __forceinline__ void do_phase(const Params& p, int l, const Frame& f) {
    if constexpr (PH == 0) { phase_rope(p, f); if (f.G == 256) phase_ada(p, 0, f.bid, f.G, f, 0, 256); else { phase_ada(p, 0, f.bid, f.G, f); phase_ada(p, 1, f.bid, f.G, f); } }
    else if constexpr (PH == 1) { phase_convert(p, l, f); if (l == 0) { phase_copy_norm(p, f); if (f.G == 256) phase_ada(p, 0, f.bid, f.G, f, 256, 9 * 128); } }
    else if constexpr (PH == 2) phase_ffn_up(p, l, 0, f);
    else if constexpr (PH == 3) phase_ffn_down<0>(p, l, f);
    else if constexpr (PH == 5) phase_win(p, l, f);
    else if constexpr (PH == 6) phase_delta_prep(p, l, f);
    else if constexpr (PH == 7) phase_scan(p, l, f);
    else if constexpr (PH == 107) phase_scan(p, l, f, PROBE_SCAN_MASK);
    else if constexpr (PH == 8) phase_merge(p, l, f);
    else if constexpr (PH == 9) phase_br(p, l, f);
    else if constexpr (PH == 10) phase_wout(p, l, f);
    else if constexpr (PH == 12) phase_ffn_up(p, l, 1, f);
    else if constexpr (PH == 13) phase_ffn_down<1>(p, l, f);
    else if constexpr (PH == 14) phase_final_norm(p, f);
}
__device__ __forceinline__ Frame make_frame(unsigned char* lds_generic, const Params& p) {
    int t = threadIdx.x; asm volatile("" : "+v"(t));
    int b = blockIdx.x; asm volatile("" : "+s"(b));
    Frame f; f.tid = t; f.wid = __builtin_amdgcn_readfirstlane(t >> 6); f.lane = t & 63; f.bid = b; f.G = gridDim.x;
    size_t z = 0; asm volatile("" : "+s"(z));
    f.ws = p.ws + z; f.out = p.out + z;
    f.lds = (LAS unsigned char*)lds_generic; return f;
}

#if ONE_LAUNCH
__global__ void __launch_bounds__(512, 2) mega_fwd(Params p, int step_first, int step_last) {
    extern __shared__ __attribute__((aligned(16))) unsigned char lds_raw[];
    volatile LAS unsigned* xbw = (volatile LAS unsigned*)((LAS unsigned char*)lds_raw + LDS_WORK);
    if (threadIdx.x < 4) xbw[threadIdx.x] = 0u;
    __syncthreads();
    XcdBarrier bar = xcd_barrier_post((unsigned*)(p.ws + WS_CTL), xbw);
#ifndef PROBE_DUP
#define PROBE_DUP 0
#endif
#define MK_PHASE(k) if (step >= step_first && step < step_last) { { const Frame f = make_frame(lds_raw, p); do_phase<k>(p, l, f); } xcd_barrier(bar); if (PROBE_BAR) xcd_barrier(bar); } ++step; \
    if constexpr ((PROBE_DUP >> k) & 1) { { const Frame f = make_frame(lds_raw, p); do_phase<(k == 7 ? 107 : k)>(p, l, f); } xcd_barrier(bar); }
    int step = 0;
#pragma unroll 1
    for (int l = 0; l < 2; ++l) {
        if (l == 0) { MK_PHASE(0) }
        if (l == 0 || gridDim.x != 256) { MK_PHASE(1) }
        MK_PHASE(2) MK_PHASE(3) MK_PHASE(5) MK_PHASE(6) MK_PHASE(7) MK_PHASE(8) MK_PHASE(9) MK_PHASE(10) MK_PHASE(12) MK_PHASE(13)
    }
    if (step_last < 1000) return;
    const Frame f = make_frame(lds_raw, p);
    do_phase<14>(p, 0, f);
}
#else
template <int PH> __global__ void __launch_bounds__(512, 2) phase_kernel(Params p, int l) {
    extern __shared__ __attribute__((aligned(16))) unsigned char lds_raw[];
    const Frame f = make_frame(lds_raw, p);
    do_phase<PH>(p, l, f);
}
template <int PH> static void launch_phase(const Params& p, int l, int grid, hipStream_t stream) {
    static bool attr_done = false;
    if (!attr_done) { (void)hipFuncSetAttribute((const void*)phase_kernel<PH>, hipFuncAttributeMaxDynamicSharedMemorySize, LDS_BYTES); attr_done = true; }
    hipLaunchKernelGGL(phase_kernel<PH>, dim3(grid), dim3(NTHREADS), LDS_BYTES, stream, p, l);
}
#endif

#if !ONE_LAUNCH
__global__ void dump_kernel(Params p, size_t off_bytes, int nslices) {
    const bf16_t* b = (const bf16_t*)(p.ws + off_bytes);
    const size_t n = 12582912;
    for (size_t i = (size_t)blockIdx.x * blockDim.x + threadIdx.x; i < 2 * n; i += (size_t)gridDim.x * blockDim.x) {
        float v = 1.0f;
        if (i < n) { v = 0.f; for (int k = 0; k < nslices; ++k) v += (float)(k + 1) * bflo((unsigned)b[(size_t)k * n + i]); }
        p.out[i] = v;
    }
}
#endif
extern "C" void kernel_launch(void* const* d_in, const int* in_sizes, int n_in, void* d_out, int out_size, void* d_ws, size_t ws_size, hipStream_t stream) {
    if (n_in != N_INPUTS || (size_t)out_size != OUT_TOTAL || ws_size < WS_END) {
        fprintf(stderr, "kernel_launch: unexpected sizes: n_in %d out %d ws %zu (need %zu); nothing launched\n", n_in, out_size, ws_size, (size_t)WS_END); return; }
    Params p{};
    for (int i = 0; i < N_INPUTS; ++i) p.in[i] = (const float*)d_in[i];
    p.out = (float*)d_out; p.ws = (unsigned char*)d_ws;
    if (hipMemsetAsync((char*)d_ws + WS_CTL, 0, CTL_BYTES, stream) != hipSuccess) { fprintf(stderr, "kernel_launch: memset failed\n"); return; }
    static int grid = 0;
    if (!grid) {
        int dev = 0, cus = 0;
        if (hipGetDevice(&dev) != hipSuccess || hipDeviceGetAttribute(&cus, hipDeviceAttributeMultiprocessorCount, dev) != hipSuccess || cus <= 0) cus = 256;
        grid = cus;
#if ONE_LAUNCH
        if (hipFuncSetAttribute((const void*)mega_fwd, hipFuncAttributeMaxDynamicSharedMemorySize, LDS_BYTES) != hipSuccess) fprintf(stderr, "kernel_launch: hipFuncSetAttribute failed\n");
        int per_cu = 0;
        if (hipOccupancyMaxActiveBlocksPerMultiprocessor(&per_cu, (const void*)mega_fwd, NTHREADS, LDS_BYTES) != hipSuccess || per_cu < 1)
            fprintf(stderr, "kernel_launch: occupancy query reports %d workgroups per CU\n", per_cu);
#endif
    }
#if ONE_LAUNCH
#ifndef SPLIT_AT
    hipLaunchKernelGGL(mega_fwd, dim3(grid), dim3(NTHREADS), LDS_BYTES, stream, p, 0, 1000);
#else
    hipLaunchKernelGGL(mega_fwd, dim3(grid), dim3(NTHREADS), LDS_BYTES, stream, p, 0, (int)(SPLIT_AT));
    if (hipMemsetAsync((char*)d_ws + WS_CTL, 0, 16384, stream) != hipSuccess) return;
    hipLaunchKernelGGL(mega_fwd, dim3(grid), dim3(NTHREADS), LDS_BYTES, stream, p, (int)(SPLIT_AT), 1000);
#endif
#else
#ifndef STOP_AT
#define STOP_AT 1000
#endif
    int step = 0;
#define LP(k) if (step++ < STOP_AT) launch_phase<k>(p, l, grid, stream);
    for (int l = 0; l < 2; ++l) { if (l == 0) { LP(0) } LP(1) LP(2) LP(3) LP(5) LP(6) LP(7) LP(8) LP(9) LP(10) LP(12) LP(13) }
#ifdef DUMP_OFF
    hipLaunchKernelGGL(dump_kernel, dim3(2048), dim3(256), 0, stream, p, (size_t)(DUMP_OFF), (int)(DUMP_N));
#endif
    if (STOP_AT >= 1000)
    launch_phase<14>(p, 0, grid, stream);
#endif
}
```

```cpp
#include <hip/hip_runtime.h>
#include <cstdio>
#include <cstdint>

#define XB_TMO      128
#define XB_XCNT(j)  (256  + 64 * (j))
#define XB_XSUB(j)  (1280 + 64 * (j))
#define XB_XGEN(j)  (2304 + 64 * (j))
#define XB_TOP      3328
#define XB_TOPGEN   3392
#define XCD_BAR_WORDS 3456
#define XB_SPIN_CAP (1u << 18)
#define LAS __attribute__((address_space(3)))

__device__ __forceinline__ unsigned xb_ld(unsigned* p)              { return __hip_atomic_load(p, __ATOMIC_RELAXED, __HIP_MEMORY_SCOPE_AGENT); }
__device__ __forceinline__ unsigned xb_add(unsigned* p, unsigned v) { return __hip_atomic_fetch_add(p, v, __ATOMIC_RELAXED, __HIP_MEMORY_SCOPE_AGENT); }
__device__ __forceinline__ unsigned xb_xcc_id() { return (unsigned)__builtin_amdgcn_s_getreg((3 << 11) | 20) & 0xFu; }
#define XB_SPIN(cond, bar) do { unsigned _sp = 0; while (cond) { __builtin_amdgcn_s_sleep(1); \
    if ((++_sp & 255u) == 0u) { if (xb_ld(&(bar)[XB_TMO])) break; if (_sp > XB_SPIN_CAP) { atomicAdd(&(bar)[XB_TMO], 1u); break; } } } } while (0)

struct XcdBarrier {
    unsigned* bar; unsigned x;
    volatile LAS unsigned* st;
};

__device__ __forceinline__ XcdBarrier xcd_barrier_post(unsigned* bar, volatile LAS unsigned* st) {
    XcdBarrier b; b.bar = bar; b.x = xb_xcc_id(); b.st = st;
    if (threadIdx.x == 0) (void)xb_add(&bar[XB_XCNT(b.x)], 1u);
    return b;
}
__device__ __forceinline__ void xcd_barrier_complete(unsigned* bar, unsigned x, unsigned& nloc, unsigned& nx) {
    const unsigned G = gridDim.x * gridDim.y * gridDim.z;
    unsigned sum, cnt, mine, sp = 0u;
    for (;;) {
        sum = 0u; cnt = 0u; mine = 0u;
#pragma unroll
        for (unsigned j = 0; j < 16; ++j) { const unsigned c = xb_ld(&bar[XB_XCNT(j)]); sum += c; cnt += (c > 0u) ? 1u : 0u; mine = (j == x) ? c : mine; }
        if (sum == G) break;
        __builtin_amdgcn_s_sleep(1);
        if ((++sp & 255u) == 0u) { if (xb_ld(&bar[XB_TMO])) break; if (sp > XB_SPIN_CAP) { atomicAdd(&bar[XB_TMO], 1u); break; } }
    }
    nloc = mine > 0u ? mine : 1u; nx = cnt > 0u ? cnt : 1u;
}

__device__ __forceinline__ void xcd_barrier(const XcdBarrier& b) {
    asm volatile("s_waitcnt vmcnt(0)" ::: "memory");
    __syncthreads();
    if (threadIdx.x == 0) {
        unsigned* bar = b.bar;
        __builtin_amdgcn_s_waitcnt(0);
        unsigned nloc = b.st[0], nx = b.st[1];
        if (nloc == 0u) { xcd_barrier_complete(bar, b.x, nloc, nx); b.st[0] = nloc; b.st[1] = nx; }
        const unsigned old = xb_add(&bar[XB_XSUB(b.x)], 1u);
        const unsigned gen = old / nloc;
        if (old + 1u == (gen + 1u) * nloc) {
            __builtin_amdgcn_fence(__ATOMIC_RELEASE, "agent");
            asm volatile("s_waitcnt vmcnt(0)" ::: "memory");
            const unsigned og = xb_add(&bar[XB_TOP], 1u);
            const unsigned tg = og / nx;
            if (og + 1u == (tg + 1u) * nx) xb_add(&bar[XB_TOPGEN], 1u);
            else XB_SPIN(xb_ld(&bar[XB_TOPGEN]) == tg, bar);
            __builtin_amdgcn_fence(__ATOMIC_ACQUIRE, "agent");
            xb_add(&bar[XB_XGEN(b.x)], 1u);
            asm volatile("s_waitcnt vmcnt(0)" ::: "memory");
        } else {
            XB_SPIN(xb_ld(&bar[XB_XGEN(b.x)]) == gen, bar);
            __builtin_amdgcn_fence(__ATOMIC_ACQUIRE, "agent");
            asm volatile("s_waitcnt vmcnt(0)" ::: "memory");
        }
    }
    __syncthreads();
}


namespace pg8 {
#define PG8_LAS __attribute__((address_space(3)))
typedef unsigned short bf16_t;
typedef short bf16x8 __attribute__((ext_vector_type(8)));
typedef float f32x4 __attribute__((ext_vector_type(4)));
typedef unsigned u32x4 __attribute__((ext_vector_type(4)));
typedef unsigned u32x2 __attribute__((ext_vector_type(2)));
constexpr int BM = 256, BK = 64, HALF = 128, HTB = HALF * BK * 2  , STAGE_BYTES = 8 * HTB, NXCD = 8, WGM = 4;

__host__ __device__ __forceinline__ int lds_byte(int r, int c) { const int st = (r >> 4) * 2 + (c >> 5), rr = r & 15, cc = c & 31, ob = rr * 64 + cc * 2; return st * 1024 + (ob ^ (((ob >> 9) & 1) << 5)); }
__host__ __device__ __forceinline__ void stage_rc(int b, int& R, int& C) { const int st = b / 1024, sb = b % 1024, swz = sb ^ (((sb >> 9) & 1) << 5); R = (st >> 1) * 16 + swz / 64; C = (st & 1) * 32 + (swz % 64) / 2; }
__host__ __device__ __forceinline__ int perm32(int rho) { const int n = rho >> 4, i = rho & 15; return 8 * (i >> 2) + 4 * n + (i & 3); }

struct Unit { int pm, pn; };
struct Gemm { const bf16_t* A; const bf16_t* Bt; int M, N, K; };

struct StaticOrder {
    int nM, nN, nwg, G, c, wgm;
    __host__ __device__ void init(int M, int N, int G_, int c_, int wgm_ = WGM) { nM = M / BM; nN = N / BM; nwg = nM * nN; G = G_; c = c_; wgm = wgm_; }
    __host__ __device__ bool next(int i, Unit& u) const {
        const long L = (long)i * G + c; if (L >= nwg) return false;
        int wgid = (int)L; { const int q = nwg / NXCD, r = nwg % NXCD, xcd = wgid % NXCD, off = wgid / NXCD; wgid = (xcd < r ? xcd * (q + 1) : r * (q + 1) + (xcd - r) * q) + off; }
        const int nig = wgm * nN, gid = wgid / nig, fm = gid * wgm, gsz = (nM - fm) < wgm ? (nM - fm) : wgm;
        u.pm = fm + ((wgid % nig) % gsz); u.pn = (wgid % nig) / gsz; return true;
    }
    __device__ __forceinline__ void a_ready(const Unit&) const {}
    __device__ __forceinline__ void done(const Unit&) const {}
};

typedef __bf16 bf16x2_t __attribute__((ext_vector_type(2)));
typedef float f32x2_t __attribute__((ext_vector_type(2)));
__device__ __forceinline__ unsigned cvt_pk_bf16(float lo, float hi) { const f32x2_t v = {lo, hi}; const bf16x2_t b = __builtin_convertvector(v, bf16x2_t); return __builtin_bit_cast(unsigned, b); }
__device__ __forceinline__ float fsigmoid(float x) { return __builtin_amdgcn_rcpf(1.0f + __expf(-x)); }
__device__ __forceinline__ float fsilu(float x) { return x * __builtin_amdgcn_rcpf(1.0f + __expf(-x)); }
__device__ __forceinline__ float bflo(unsigned w) { return __uint_as_float(w << 16); }
__device__ __forceinline__ float bfhi(unsigned w) { return __uint_as_float(w & 0xffff0000u); }

struct EpiSwiglu {
    static constexpr bool PERM = true, AFTER_DRAIN = false;
    bf16_t* O; int ldo; const float* SS; const float* shW;
    __device__ __forceinline__ void operator()(const f32x4 (&acc)[2][2][4][2], const Unit& u, int wr, int wc, int fr, int fq) const {
        const int row0 = u.pm * BM + wr * 64 + fr, col0 = u.pn * HALF + wc * 32 + 8 * fq;
        const int rb = u.pm < 16 ? 0 : (u.pm < 32 ? 1 : 2);
        const float* sw = shW + (size_t)rb * 8192 + u.pn * BM + wc * 32 + 8 * fq;
        const f32x4 sa0 = *(const f32x4*)sw, sa1 = *(const f32x4*)(sw + 4), sb0 = *(const f32x4*)(sw + HALF), sb1 = *(const f32x4*)(sw + HALF + 4);
        float rstdv[2][4];
#pragma unroll
        for (int ai = 0; ai < 2; ++ai)
#pragma unroll
            for (int m = 0; m < 4; ++m) rstdv[ai][m] = rsqrtf(SS[row0 + ai * HALF + m * 16] * (1.0f / 2048.0f) + 1e-6f);
#pragma unroll
        for (int ai = 0; ai < 2; ++ai)
#pragma unroll
            for (int m = 0; m < 4; ++m) {
                const int row = row0 + ai * HALF + m * 16;
                const float rstd = rstdv[ai][m];
                bf16_t* rowp = O + (size_t)row * ldo + col0;
                const f32x4 a0 = acc[ai][0][m][0] * rstd + sa0, a1 = acc[ai][0][m][1] * rstd + sa1, b0 = acc[ai][1][m][0] * rstd + sb0, b1 = acc[ai][1][m][1] * rstd + sb1;
                u32x4 w;
                w.x = cvt_pk_bf16(fsilu(a0[0]) * b0[0], fsilu(a0[1]) * b0[1]); w.y = cvt_pk_bf16(fsilu(a0[2]) * b0[2], fsilu(a0[3]) * b0[3]);
                w.z = cvt_pk_bf16(fsilu(a1[0]) * b1[0], fsilu(a1[1]) * b1[1]); w.w = cvt_pk_bf16(fsilu(a1[2]) * b1[2], fsilu(a1[3]) * b1[3]);
                *(u32x4*)rowp = w;
            }
    }
};
template <int MODIDX, bool HALFSCALE> struct EpiResid {
    static constexpr bool PERM = true, AFTER_DRAIN = false;
    static constexpr int modidx = MODIDX; static constexpr float scale = HALFSCALE ? 0.5f : 1.0f;
    float* X; const float* ada;
    const float* Xrp; const float* Xrs;
    bf16_t* XB; const float* gnext; const float* scnext; float* SS; int has_xb;
    __device__ __forceinline__ void operator()(const f32x4 (&acc)[2][2][4][2], const Unit& u, int wr, int wc, int fr, int fq) const {
        const int rb = u.pm < 16 ? 0 : (u.pm < 32 ? 1 : 2);
        const float* mv = ada + (size_t)(rb * 9 + modidx) * 2048;
        const int row0 = u.pm * BM + wr * 64 + fr, col0 = u.pn * BM + wc * 32 + 8 * fq;
        f32x4 mvv[2][2], gsv[2][2];
#pragma unroll
        for (int bj = 0; bj < 2; ++bj)
#pragma unroll
            for (int n = 0; n < 2; ++n) { const int c = col0 + bj * HALF + n * 4; mvv[bj][n] = *(const f32x4*)(mv + c) * scale;
                gsv[bj][n] = has_xb ? *(const f32x4*)(gnext + c) * (*(const f32x4*)(scnext + (size_t)rb * 9 * 2048 + c) + 1.0f) : (f32x4){0.f, 0.f, 0.f, 0.f}; }
#pragma unroll
        for (int ai = 0; ai < 2; ++ai)
#pragma unroll
            for (int mp = 0; mp < 2; ++mp) {
                f32x4 xr[2][2][2];
#pragma unroll
                for (int mm = 0; mm < 2; ++mm)
#pragma unroll
                    for (int bj = 0; bj < 2; ++bj) { const size_t row = (size_t)(row0 + ai * HALF + (2 * mp + mm) * 16);
                        const f32x4* r0 = (const f32x4*)((u.pm < 16 ? Xrp : Xrs) + row * 2048 + col0 + bj * HALF); xr[mm][bj][0] = r0[0]; xr[mm][bj][1] = r0[1]; }
#pragma unroll
                for (int mm = 0; mm < 2; ++mm) { const int m = 2 * mp + mm; const size_t row = (size_t)(row0 + ai * HALF + m * 16); float* rowp = X + row * 2048 + col0; float ssq = 0.f;
#pragma unroll
                    for (int bj = 0; bj < 2; ++bj) {
                        f32x4* p0 = (f32x4*)(rowp + bj * HALF); f32x4* p1 = p0 + 1;
                        const f32x4 x0 = xr[mm][bj][0] + mvv[bj][0] * acc[ai][bj][m][0], x1 = xr[mm][bj][1] + mvv[bj][1] * acc[ai][bj][m][1];
                        *p0 = x0; *p1 = x1;
                        ssq += ((x0[0] * x0[0] + x0[1] * x0[1]) + (x0[2] * x0[2] + x0[3] * x0[3])) + ((x1[0] * x1[0] + x1[1] * x1[1]) + (x1[2] * x1[2] + x1[3] * x1[3]));
                        if (has_xb) { const f32x4 y0 = x0 * gsv[bj][0], y1 = x1 * gsv[bj][1];
                            u32x4 w; w.x = cvt_pk_bf16(y0[0], y0[1]); w.y = cvt_pk_bf16(y0[2], y0[3]); w.z = cvt_pk_bf16(y1[0], y1[1]); w.w = cvt_pk_bf16(y1[2], y1[3]);
                            *(u32x4*)(XB + row * 2048 + col0 + bj * HALF) = w; } }
                    ssq += __shfl_xor(ssq, 16); ssq += __shfl_xor(ssq, 32);
                    if (fq == 0) atomicAdd(SS + row, ssq); }
            }
    }
};
struct EpiWin {
    static constexpr bool PERM = true, AFTER_DRAIN = false;
    bf16_t* PQ; bf16_t* PG; float* GT; const float* biasp; const float* SS; const float* shW;
    __device__ __forceinline__ void operator()(const f32x4 (&acc)[2][2][4][2], const Unit& u, int wr, int wc, int fr, int fq) const {
        const int pn = u.pn, row0 = u.pm * BM + wr * 64 + fr, tc = wc * 32 + 8 * fq;
        f32x4 bv[2][2];
#pragma unroll
        for (int bj = 0; bj < 2; ++bj)
#pragma unroll
            for (int n = 0; n < 2; ++n) bv[bj][n] = *(const f32x4*)(biasp + pn * BM + bj * HALF + tc + 4 * n) + *(const f32x4*)(shW + (size_t)(u.pm < 16 ? 0 : (u.pm < 32 ? 1 : 2)) * 18688 + pn * BM + bj * HALF + tc + 4 * n);
        float rstd[2][4];
#pragma unroll
        for (int ai = 0; ai < 2; ++ai)
#pragma unroll
            for (int m = 0; m < 4; ++m) rstd[ai][m] = rsqrtf(SS[row0 + ai * HALF + m * 16] * (1.0f / 2048.0f) + 1e-6f);
        if (pn == 72) {
            if (wc < 2) {
#pragma unroll
                for (int ai = 0; ai < 2; ++ai)
#pragma unroll
                    for (int m = 0; m < 4; ++m) { float* rowp = GT + (size_t)(row0 + ai * HALF + m * 16) * 64 + tc;
                        *(f32x4*)rowp = acc[ai][0][m][0] * rstd[ai][m] + bv[0][0]; *(f32x4*)(rowp + 4) = acc[ai][0][m][1] * rstd[ai][m] + bv[0][1]; }
            }
            return;
        }
        bf16_t* base; int colt, act;
        if (pn < 36) { base = PQ; colt = pn * BM; act = 0; } else { const int q = pn - 36; base = PG; colt = q * BM; act = (q < 4) ? 1 : ((q < 12) ? 2 : 1); }
#pragma unroll
        for (int ai = 0; ai < 2; ++ai)
#pragma unroll
            for (int m = 0; m < 4; ++m) { bf16_t* rowp = base + (size_t)(row0 + ai * HALF + m * 16) * 9216 + colt + tc;
#pragma unroll
                for (int bj = 0; bj < 2; ++bj) { f32x4 v0 = acc[ai][bj][m][0] * rstd[ai][m] + bv[bj][0], v1 = acc[ai][bj][m][1] * rstd[ai][m] + bv[bj][1];
                    if (act == 1) {
#pragma unroll
                        for (int j = 0; j < 4; ++j) { v0[j] = fsigmoid(v0[j]); v1[j] = fsigmoid(v1[j]); } }
                    else if (act == 2) {
#pragma unroll
                        for (int j = 0; j < 4; ++j) { v0[j] = fsilu(v0[j]); v1[j] = fsilu(v1[j]); } }
                    u32x4 w; w.x = cvt_pk_bf16(v0[0], v0[1]); w.y = cvt_pk_bf16(v0[2], v0[3]); w.z = cvt_pk_bf16(v1[0], v1[1]); w.w = cvt_pk_bf16(v1[2], v1[3]);
                    *(u32x4*)(rowp + bj * HALF) = w; } }
    }
};
struct EpiBr {
    static constexpr bool PERM = true, AFTER_DRAIN = false;
    const bf16_t* PG; float* TMP; bf16_t* OUT; int seg;
    __device__ __forceinline__ void operator()(const f32x4 (&acc)[2][2][4][2], const Unit& u, int wr, int wc, int fr, int fq) const {
        const int row0 = u.pm * BM + wr * 64 + fr, col0 = u.pn * BM + wc * 32 + 8 * fq;
#pragma unroll
        for (int ai = 0; ai < 2; ++ai)
#pragma unroll
            for (int mp = 0; mp < 2; ++mp) {
                u32x4 gwv[2][2], tv[2][2];
#pragma unroll
                for (int mm = 0; mm < 2; ++mm)
#pragma unroll
                    for (int bj = 0; bj < 2; ++bj) { const size_t row = (size_t)(row0 + ai * HALF + (2 * mp + mm) * 16); const int c = col0 + bj * HALF;
                        gwv[mm][bj] = *(const u32x4*)(PG + row * 9216 + 3072 + seg * 2048 + c);
                        tv[mm][bj] = (seg != 0) ? *(const u32x4*)(OUT + row * 2048 + c) : (u32x4){0u, 0u, 0u, 0u}; }
#pragma unroll
                for (int mm = 0; mm < 2; ++mm)
#pragma unroll
                    for (int bj = 0; bj < 2; ++bj) { const int m = 2 * mp + mm; const size_t row = (size_t)(row0 + ai * HALF + m * 16); const int c = col0 + bj * HALF;
                        const u32x4 gw = gwv[mm][bj], t = tv[mm][bj];
                        f32x4 v0 = acc[ai][bj][m][0], v1 = acc[ai][bj][m][1];
                        v0[0] = v0[0] * bflo(gw.x) + bflo(t.x); v0[1] = v0[1] * bfhi(gw.x) + bfhi(t.x); v0[2] = v0[2] * bflo(gw.y) + bflo(t.y); v0[3] = v0[3] * bfhi(gw.y) + bfhi(t.y);
                        v1[0] = v1[0] * bflo(gw.z) + bflo(t.z); v1[1] = v1[1] * bfhi(gw.z) + bfhi(t.z); v1[2] = v1[2] * bflo(gw.w) + bflo(t.w); v1[3] = v1[3] * bfhi(gw.w) + bfhi(t.w);
                        u32x4 w; w.x = cvt_pk_bf16(v0[0], v0[1]); w.y = cvt_pk_bf16(v0[2], v0[3]); w.z = cvt_pk_bf16(v1[0], v1[1]); w.w = cvt_pk_bf16(v1[2], v1[3]);
                        *(u32x4*)(OUT + row * 2048 + c) = w; }
            }
    }
};

template <class Epi, class Sched, bool ALIGN_EPI = false, bool SP2 = false>
__device__ __forceinline__ void gemm_phase(PG8_LAS unsigned char* lds, const Gemm g, const Sched& S, const Epi& E) {
    int tid_raw = threadIdx.x; asm volatile("" : "+v"(tid_raw));
    const int tid = tid_raw, wid = __builtin_amdgcn_readfirstlane(tid >> 6), lane = tid & 63, wr = wid >> 2, wc = wid & 3, fr = lane & 15, fq = lane >> 4;
    const int K = g.K, nt = K / BK;
    unsigned voffA[2], voffB[2];
#pragma unroll
    for (int i = 0; i < 2; ++i) { int R, C; stage_rc(tid * 16 + i * 8192, R, C); const int Rb = Epi::PERM ? ((R & ~31) + perm32(R & 31)) : R;
        voffA[i] = (unsigned)(R * K + C) * 2u; voffB[i] = (unsigned)(Rb * K + C) * 2u; }
    const size_t kstep = (size_t)(BK * 2);
    const size_t hstep = (size_t)HALF * K * 2;
    const size_t tstep = 2 * hstep;
    const unsigned ldsw = (unsigned)wid * 1024u;
    const int aoff = lds_byte(wr * 64 + fr, fq * 8), boff = lds_byte(wc * 32 + fr, fq * 8);
#define PG8_SA(b, h) (((b) * 2 + (h)) * HTB)
#define PG8_SB(b, h) ((4 + (b) * 2 + (h)) * HTB)
#define PG8_STAGE(bufoff, gbase, voff) do { _Pragma("unroll") for (int _i = 0; _i < 2; ++_i) \
        __builtin_amdgcn_global_load_lds((const unsigned*)((const char*)(gbase) + (voff)[_i]), (PG8_LAS unsigned*)(lds + (bufoff) + ldsw + _i * 8192), 16, 0, 0); } while (0)
#define PG8_LDA(dst, b, h) do { _Pragma("unroll") for (int m = 0; m < 4; ++m) _Pragma("unroll") for (int k = 0; k < 2; ++k) dst[m][k] = *(const PG8_LAS bf16x8*)(lds + PG8_SA(b, h) + aoff + m * 2048 + k * 1024); } while (0)
#define PG8_LDB(dst, b, h) do { _Pragma("unroll") for (int n = 0; n < 2; ++n) _Pragma("unroll") for (int k = 0; k < 2; ++k) dst[n][k] = *(const PG8_LAS bf16x8*)(lds + PG8_SB(b, h) + boff + n * 2048 + k * 1024); } while (0)
#define PG8_MMA(ai, bj, At, Bt) do { __builtin_amdgcn_s_setprio(1); _Pragma("unroll") for (int m = 0; m < 4; ++m) _Pragma("unroll") for (int n = 0; n < 2; ++n) _Pragma("unroll") for (int k = 0; k < 2; ++k) \
        acc[ai][bj][m][n] = __builtin_amdgcn_mfma_f32_16x16x32_bf16(Bt[n][k], At[m][k], acc[ai][bj][m][n], 0, 0, 0); __builtin_amdgcn_s_setprio(0); } while (0)
#define PG8_WAIT_V(n) asm volatile("s_waitcnt vmcnt(" #n ")" ::: "memory")
#define PG8_WAIT_L(n) asm volatile("s_waitcnt lgkmcnt(" #n ")" ::: "memory")
#define PG8_BAR __builtin_amdgcn_s_barrier()
#define PG8_SCHED __builtin_amdgcn_sched_barrier(0)
    Unit cur, nxt; int ui = 0;
    if (!S.next(0, cur)) return;
    f32x4 acc[2][2][4][2];
#pragma unroll
    for (int a = 0; a < 2; ++a)
#pragma unroll
        for (int b = 0; b < 2; ++b)
#pragma unroll
            for (int m = 0; m < 4; ++m)
#pragma unroll
                for (int n = 0; n < 2; ++n) acc[a][b][m][n] = (f32x4){0.f, 0.f, 0.f, 0.f};
    bf16x8 At[4][2], B0[2][2], B1[2][2];
    const char* cA = (const char*)g.A + (size_t)cur.pm * tstep; const char* cB = (const char*)g.Bt + (size_t)cur.pn * tstep;
    S.a_ready(cur);
    if constexpr (SP2) {
        PG8_STAGE(PG8_SB(0, 0), cB, voffB); PG8_STAGE(PG8_SB(0, 1), cB + hstep, voffB); PG8_STAGE(PG8_SA(0, 0), cA, voffA); PG8_STAGE(PG8_SA(0, 1), cA + hstep, voffA);
        if (wr == 1) PG8_BAR;
        PG8_WAIT_V(2); PG8_BAR;
        PG8_STAGE(PG8_SB(1, 0), cB + kstep, voffB); PG8_STAGE(PG8_SA(1, 0), cA + kstep, voffA); PG8_STAGE(PG8_SB(1, 1), cB + hstep + kstep, voffB);
        PG8_WAIT_V(6); PG8_BAR;
    } else {
        PG8_STAGE(PG8_SB(0, 0), cB, voffB); PG8_STAGE(PG8_SA(0, 0), cA, voffA); PG8_STAGE(PG8_SB(0, 1), cB + hstep, voffB); PG8_STAGE(PG8_SA(0, 1), cA + hstep, voffA);
        if (wr == 1) PG8_BAR;
        PG8_WAIT_V(4); PG8_BAR;
        PG8_STAGE(PG8_SB(1, 0), cB + kstep, voffB); PG8_STAGE(PG8_SA(1, 0), cA + kstep, voffA); PG8_STAGE(PG8_SB(1, 1), cB + hstep + kstep, voffB);
        PG8_WAIT_V(6); PG8_BAR;
    }
    for (;;) {
        const bool has_next = S.next(ui + 1, nxt);
        const char* nA = has_next ? (const char*)g.A + (size_t)nxt.pm * tstep : cA; const char* nB = has_next ? (const char*)g.Bt + (size_t)nxt.pn * tstep : cB;
        for (int t = 0; t < nt; t += 2) {
            const bool last = (t == nt - 2);
            const char* a1 = cA + (size_t)(t + 1) * kstep;
            const char* a2 = last ? nA : cA + (size_t)(t + 2) * kstep; const char* b2 = last ? nB : cB + (size_t)(t + 2) * kstep;
            const char* a3 = a2 + kstep; const char* b3 = b2 + kstep;
            if (last && has_next) S.a_ready(nxt);
            if constexpr (SP2) {
            PG8_LDB(B0, 0, 0); PG8_LDB(B1, 0, 1); PG8_SCHED; PG8_LDA(At, 0, 0); PG8_STAGE(PG8_SA(1, 1), a1 + hstep, voffA);
            PG8_WAIT_V(8); PG8_WAIT_L(0); PG8_BAR; PG8_MMA(0, 0, At, B0); PG8_MMA(0, 1, At, B1); PG8_BAR; PG8_SCHED;
            PG8_LDA(At, 0, 1); PG8_STAGE(PG8_SB(0, 0), b2, voffB); PG8_STAGE(PG8_SB(0, 1), b2 + hstep, voffB); PG8_STAGE(PG8_SA(0, 0), a2, voffA);
            PG8_WAIT_V(8); PG8_WAIT_L(0); PG8_BAR; PG8_MMA(1, 0, At, B0); PG8_MMA(1, 1, At, B1); PG8_BAR; PG8_SCHED;
            PG8_LDB(B0, 1, 0); PG8_LDB(B1, 1, 1); PG8_SCHED; PG8_LDA(At, 1, 0); PG8_STAGE(PG8_SA(0, 1), a2 + hstep, voffA);
            PG8_WAIT_V(8); PG8_WAIT_L(0); PG8_BAR; PG8_MMA(0, 0, At, B0); PG8_MMA(0, 1, At, B1); PG8_BAR; PG8_SCHED;
            PG8_LDA(At, 1, 1); PG8_STAGE(PG8_SB(1, 0), b3, voffB); PG8_STAGE(PG8_SB(1, 1), b3 + hstep, voffB); PG8_STAGE(PG8_SA(1, 0), a3, voffA);
            PG8_WAIT_V(8); PG8_WAIT_L(0); PG8_BAR; PG8_MMA(1, 0, At, B0); PG8_MMA(1, 1, At, B1); PG8_BAR; PG8_SCHED;
            } else {
            PG8_LDB(B0, 0, 0); PG8_SCHED; PG8_LDA(At, 0, 0); PG8_STAGE(PG8_SA(1, 1), a1 + hstep, voffA);
            PG8_WAIT_L(8); PG8_BAR; PG8_WAIT_L(0); PG8_MMA(0, 0, At, B0); PG8_BAR; PG8_SCHED;
            PG8_LDB(B1, 0, 1); PG8_STAGE(PG8_SB(0, 0), b2, voffB);
            PG8_BAR; PG8_WAIT_L(0); PG8_MMA(0, 1, At, B1); PG8_BAR;
            PG8_LDA(At, 0, 1); PG8_STAGE(PG8_SA(0, 0), a2, voffA);
            PG8_BAR; PG8_WAIT_L(0); PG8_MMA(1, 0, At, B0); PG8_BAR; PG8_SCHED;
            PG8_STAGE(PG8_SB(0, 1), b2 + hstep, voffB);
            PG8_WAIT_V(6); PG8_BAR; PG8_MMA(1, 1, At, B1); PG8_BAR;
            PG8_LDB(B0, 1, 0); PG8_SCHED; PG8_LDA(At, 1, 0); PG8_STAGE(PG8_SA(0, 1), a2 + hstep, voffA);
            PG8_WAIT_L(8); PG8_BAR; PG8_WAIT_L(0); PG8_MMA(0, 0, At, B0); PG8_BAR; PG8_SCHED;
            PG8_LDB(B1, 1, 1); PG8_STAGE(PG8_SB(1, 0), b3, voffB);
            PG8_BAR; PG8_WAIT_L(0); PG8_MMA(0, 1, At, B1); PG8_BAR;
            PG8_LDA(At, 1, 1); PG8_STAGE(PG8_SA(1, 0), a3, voffA);
            PG8_BAR; PG8_WAIT_L(0); PG8_MMA(1, 0, At, B0); PG8_BAR; PG8_SCHED;
            PG8_STAGE(PG8_SB(1, 1), b3 + hstep, voffB);
            PG8_WAIT_V(6); PG8_BAR; PG8_MMA(1, 1, At, B1); PG8_BAR;
            }
        }
        if constexpr (ALIGN_EPI) { if (wr == 0) PG8_BAR; }
        if constexpr (!Epi::AFTER_DRAIN) { E(acc, cur, wr, wc, fr, fq); S.done(cur); }
        if (!has_next) break;
#pragma unroll
        for (int a = 0; a < 2; ++a)
#pragma unroll
            for (int b = 0; b < 2; ++b)
#pragma unroll
                for (int m = 0; m < 4; ++m)
#pragma unroll
                    for (int n = 0; n < 2; ++n) acc[a][b][m][n] = (f32x4){0.f, 0.f, 0.f, 0.f};
        cur = nxt; cA = nA; cB = nB; ++ui;
        if constexpr (ALIGN_EPI) { if (wr == 1) PG8_BAR; }
    }
    PG8_WAIT_V(0);
    if constexpr (!ALIGN_EPI) { if (wr == 0) PG8_BAR; }
    PG8_BAR;
    if constexpr (Epi::AFTER_DRAIN) { E.fused(acc, cur, wr, wc, fr, fq, lds, wid, lane); S.done(cur); }
#undef PG8_SA
#undef PG8_SB
#undef PG8_STAGE
#undef PG8_LDA
#undef PG8_LDB
#undef PG8_MMA
#undef PG8_WAIT_V
#undef PG8_WAIT_L
#undef PG8_BAR
#undef PG8_SCHED
}
}

using pg8::bf16_t; using pg8::bf16x8; using pg8::f32x4; using pg8::u32x4; using pg8::u32x2;
using pg8::cvt_pk_bf16; using pg8::bflo; using pg8::bfhi; using pg8::fsigmoid; using pg8::fsilu;

#ifndef ONE_LAUNCH
#define ONE_LAUNCH 1
#define PROBE_SCAN_MASK 7
#define PROBE_SEG 0
#define PROBE_PREP 0
#define WGM_WIN 4
#define WGM_UP 4
#define WGM_N2K 4
#define PROBE_BAR 0

#endif

constexpr int DM = 2048, MROWS = 12288, NTHREADS = 512, NWAVES = 8;
constexpr int NINP = 18688, NIN = 18496;
constexpr int LDQ = 9216;
constexpr float EPS = 1e-6f;
constexpr float QSCALE = 0.08838834764831845f;

enum { I_XP = 0, I_XS, I_SC, I_SN, I_SM, I_SD, I_SR, I_C, I_CCTX, I_NORMG, I_FNG, I_WADA, I_BADA, I_WIN, I_BIN, I_FBIAS, I_CONVW, I_ALOG, I_DTB, I_LGAM, I_HNG, I_WBR, I_WOUT, I_W13, I_W2, N_INPUTS };

constexpr size_t OUT_Y = 0, OUT_C = 25165824, OUT_N = OUT_C + 8388608, OUT_M = OUT_N + 65536, OUT_DS = OUT_M + 512, OUT_RS = OUT_DS + 8388608, OUT_TOTAL = OUT_RS + 8388608;

constexpr size_t MiB = 1u << 20;
constexpr size_t WS_CTL = 0, CTL_BYTES = 2 * MiB;
constexpr size_t WS_QUEUE = 32768;
constexpr size_t WS_ADA = 65536;
constexpr size_t WS_SS = 512 * 1024;
constexpr size_t WS_SHW = 1 * MiB;
constexpr int SHW_LAYER = 105216, SHW_WIN = 24576, SHW_UP1 = 80640;
constexpr size_t WS_ROPE = 2 * MiB;
constexpr size_t WS_BIASP = WS_ROPE + 16384;
constexpr size_t WS_W13T = 3 * MiB;
constexpr size_t WS_W2T = WS_W13T + 64 * MiB;
constexpr size_t WS_WINT = WS_W2T + 32 * MiB;
constexpr size_t WS_WBRT = WS_WINT + 73 * MiB;
constexpr size_t WS_WOUTT = WS_WBRT + 12 * MiB;
constexpr size_t WS_PQ = WS_WOUTT + 8 * MiB;
constexpr size_t WS_PG = WS_PQ + 216 * MiB;
constexpr size_t WS_GT = WS_PG + 216 * MiB;
constexpr size_t WS_QN = WS_GT + 3 * MiB;
constexpr size_t WS_KT = WS_QN + 24 * MiB;
constexpr size_t WS_U0T = WS_KT + 24 * MiB;
constexpr size_t WS_WK = WS_U0T + 48 * MiB;
constexpr size_t WS_QKD = WS_WK + 48 * MiB;
constexpr size_t WS_GCH = WS_QKD + 24 * MiB;
constexpr size_t WS_HS = WS_GCH + 1 * MiB;
constexpr size_t WS_W1 = WS_HS + 144 * MiB;
constexpr size_t WS_BIASP1 = WS_W1 + 189 * MiB;
constexpr size_t WS_END = WS_BIASP1 + 1 * MiB;
__host__ __device__ constexpr size_t wofs(int l) { return l ? (WS_W1 - WS_W13T) : 0; }
constexpr size_t WS_HID = WS_PQ, WS_YS = WS_PQ, WS_TMP = WS_PQ + 76 * MiB, WS_H = WS_HS, WS_XB3 = WS_PQ + 100 * MiB;

constexpr int LDS_BYTES = 147456, LDS_WORK = LDS_BYTES - 64;

struct Params { const float* in[N_INPUTS]; float* out; unsigned char* ws; };

struct Frame { int tid, wid, lane, bid, G; LAS unsigned char* lds; unsigned char* ws; float* out; };

__device__ __forceinline__ int sp(int i, int dir) { return dir ? 63 - i : i; }
__device__ __forceinline__ f32x4 mfma16(bf16x8 a, bf16x8 b, f32x4 c) { return __builtin_amdgcn_mfma_f32_16x16x32_bf16(a, b, c, 0, 0, 0); }
template <int K> __device__ __forceinline__ f32x4 mm16(f32x4 acc, const LAS bf16_t* A, int lda, const LAS bf16_t* Bt, int ldb, int lane) {
    const int r = lane & 15, kq = (lane >> 4) * 8;
#pragma unroll
    for (int k0 = 0; k0 < K; k0 += 32) {
        const bf16x8 a = *(const LAS bf16x8*)(A + r * lda + k0 + kq);
        const bf16x8 b = *(const LAS bf16x8*)(Bt + r * ldb + k0 + kq);
        acc = mfma16(a, b, acc);
    }
    return acc;
}
__device__ __forceinline__ bf16_t f2bf(float f) { return (bf16_t)(cvt_pk_bf16(f, 0.f) & 0xffffu); }
__device__ __forceinline__ u32x2 pack4(f32x4 v) { u32x2 w; w.x = cvt_pk_bf16(v[0], v[1]); w.y = cvt_pk_bf16(v[2], v[3]); return w; }
__device__ __forceinline__ void unpack8(u32x4 w, float (&x)[8]) { x[0] = bflo(w.x); x[1] = bfhi(w.x); x[2] = bflo(w.y); x[3] = bfhi(w.y); x[4] = bflo(w.z); x[5] = bfhi(w.z); x[6] = bflo(w.w); x[7] = bfhi(w.w); }
__device__ __forceinline__ u32x4 pack8(const float (&x)[8]) { u32x4 w; w.x = cvt_pk_bf16(x[0], x[1]); w.y = cvt_pk_bf16(x[2], x[3]); w.z = cvt_pk_bf16(x[4], x[5]); w.w = cvt_pk_bf16(x[6], x[7]); return w; }
template <int CTRL, int ROWMASK> __device__ __forceinline__ float dppf(float old, float x) {
    return __builtin_bit_cast(float, __builtin_amdgcn_update_dpp(__builtin_bit_cast(int, old), __builtin_bit_cast(int, x), CTRL, ROWMASK, 0xF, false));
}
__device__ __forceinline__ float wave_scan_add(float x, int) {
    x += dppf<0x111, 0xF>(0.f, x); x += dppf<0x112, 0xF>(0.f, x); x += dppf<0x114, 0xF>(0.f, x); x += dppf<0x118, 0xF>(0.f, x);
    x += dppf<0x142, 0xA>(0.f, x); x += dppf<0x143, 0xC>(0.f, x);
    return x;
}
__device__ __forceinline__ float wave_scan_max(float x, int) {
    const float ninf = -__builtin_huge_valf();
    x = fmaxf(x, dppf<0x111, 0xF>(ninf, x)); x = fmaxf(x, dppf<0x112, 0xF>(ninf, x)); x = fmaxf(x, dppf<0x114, 0xF>(ninf, x)); x = fmaxf(x, dppf<0x118, 0xF>(ninf, x));
    x = fmaxf(x, dppf<0x142, 0xA>(ninf, x)); x = fmaxf(x, dppf<0x143, 0xC>(ninf, x));
    return x;
}

__device__ __forceinline__ float wave_sum(float s) {
#pragma unroll
    for (int o = 32; o >= 1; o >>= 1) s += __shfl_xor(s, o);
    return s;
}
__device__ __forceinline__ void phase_copy_norm(const Params& p, const Frame& f) {
    bf16_t* H = (bf16_t*)(f.ws + WS_H); float* SS = (float*)(f.ws + WS_SS);
    const float* g = p.in[I_NORMG]; const float* ada = (const float*)(f.ws + WS_ADA);
    for (int row = f.bid * NWAVES + f.wid; row < MROWS; row += f.G * NWAVES) {
        const int rb = row < 4096 ? 0 : (row < 8192 ? 1 : 2);
        const float* xs = (row < 4096) ? p.in[I_XP] + (size_t)row * 2048 : p.in[I_XS] + (size_t)(row - 4096) * 2048;
        const float* scl = ada + (size_t)(rb * 9 + 1) * 2048;
        f32x4 v[8]; float ss = 0.f;
#pragma unroll
        for (int it = 0; it < 8; ++it) { v[it] = *(const f32x4*)(xs + 4 * (f.lane + 64 * it)); ss += v[it][0] * v[it][0] + v[it][1] * v[it][1] + v[it][2] * v[it][2] + v[it][3] * v[it][3]; }
        ss = wave_sum(ss);
        if (f.lane == 0) SS[row] = ss;
#pragma unroll
        for (int it = 0; it < 8; ++it) { const int c = 4 * (f.lane + 64 * it);
            const f32x4 y = v[it] * *(const f32x4*)(g + c) * (*(const f32x4*)(scl + c) + 1.0f);
            *(u32x2*)(H + (size_t)row * 2048 + c) = pack4(y); }
    }
}
__device__ __forceinline__ void phase_rope(const Params& p, const Frame& f) {
    float* rope = (float*)(f.ws + WS_ROPE);
    for (int i = f.bid * NTHREADS + f.tid; i < 64 * 32; i += f.G * NTHREADS) {
        const int pos = i >> 5, fi = i & 31;
        const float freq = powf(10000.0f, -(float)fi / 32.0f), ang = (float)pos * freq;
        float s, c; sincosf(ang, &s, &c);
        rope[2 * i] = c; rope[2 * i + 1] = s;
    }
}
__device__ __forceinline__ void phase_ada(const Params& p, int l, int w, int nw, const Frame& f, int ilo = 0, int ihi = 9 * 128) {
    LAS float* sc = (LAS float*)f.lds;
    float* ada = (float*)(f.ws + WS_ADA);
#pragma unroll 1
    for (int item = ilo + w; item < ihi; item += nw) {
        const int g = item >> 7, kp = item & 127;
        __syncthreads();
        if (f.tid < 48) { const int r = f.tid >> 4, k = kp * 16 + (f.tid & 15);
            const float cv = (r == 0) ? p.in[I_CCTX][k] : p.in[I_C][(r - 1) * 2048 + k];
            sc[f.tid] = fsilu(cv); }
        __syncthreads();
        const int col = g * 2048 + f.tid * 4;
        const float* W = p.in[I_WADA] + ((size_t)l * 2048 + (size_t)kp * 16) * 18432 + col;
        f32x4 a0 = {0.f, 0.f, 0.f, 0.f}, a1 = a0, a2 = a0;
#pragma unroll
        for (int k = 0; k < 16; ++k) { const f32x4 w4 = *(const f32x4*)(W + (size_t)k * 18432); a0 += w4 * sc[k]; a1 += w4 * sc[16 + k]; a2 += w4 * sc[32 + k]; }
        if (kp == 0) { const f32x4 b = *(const f32x4*)(p.in[I_BADA] + (size_t)l * 18432 + col); a0 += b; a1 += b; a2 += b; }
        float* o = ada + (size_t)l * 3 * 18432 + col;
#pragma unroll
        for (int j = 0; j < 4; ++j) { atomicAdd(o + j, a0[j]); atomicAdd(o + 18432 + j, a1[j]); atomicAdd(o + 2 * 18432 + j, a2[j]); }
    }
}
__device__ __forceinline__ int win_src_col(int n) {
    if (n < 3072) return n;
    if (n < 6144) return 4128 + (n - 3072);
    if (n < 9216) return 8256 + (n - 6144);
    if (n < 10240) return 3072 + (n - 9216);
    if (n < 11264) return 7200 + (n - 10240);
    if (n < 12288) return 11328 + (n - 11264);
    if (n < 18432) return 12352 + (n - 12288);
    if (n < 18464) return 4096 + (n - 18432);
    if (n < 18496) return 8224 + (n - 18464);
    return -1;
}
__device__ __forceinline__ void convert_bias(const Params& p, int l, int first, int stride, const Frame& f) {
    float* biasp = (float*)(f.ws + (l ? WS_BIASP1 : WS_BIASP));
    for (int i = first * NTHREADS + f.tid; i < NINP; i += stride * NTHREADS) { const int s = win_src_col(i); biasp[i] = (s >= 0) ? p.in[I_BIN][(size_t)l * NIN + s] : 0.f; }
}
__device__ __forceinline__ void convert_item(const Params& p, int l, int item, const Frame& f) {
    {
        const size_t wo = wofs(l);
        const float* src; bf16_t* dst; int K, Nsrc, nb, kb, kind; const float* shp = nullptr; float* shd = nullptr; int shn = 0;
        if (item < 512) { const int j = item >> 8, r = item & 255; nb = r >> 1; kb = r & 1; K = 2048; Nsrc = 8192; kind = 0;
            src = p.in[I_W13] + (size_t)(l * 2 + j) * 2048 * 8192; dst = (bf16_t*)(f.ws + wo + WS_W13T) + (size_t)j * 8192 * 2048;
            shp = (const float*)(f.ws + WS_ADA) + (size_t)l * 3 * 18432 + (size_t)(j == 0 ? 0 : 6) * 2048; shd = (float*)(f.ws + WS_SHW) + (size_t)l * SHW_LAYER + (j == 0 ? 0 : SHW_UP1); shn = 8192; }
        else if (item < 768) { const int it = item - 512, j = it >> 7, r = it & 127; nb = r >> 2; kb = r & 3; K = 4096; Nsrc = 2048; kind = 1;
            src = p.in[I_W2] + (size_t)(l * 2 + j) * 4096 * 2048; dst = (bf16_t*)(f.ws + wo + WS_W2T) + (size_t)j * 2048 * 4096; }
        else if (item < 1352) { const int it = item - 768; nb = it >> 1; kb = it & 1; K = 2048; Nsrc = NIN; kind = 2;
            src = p.in[I_WIN] + (size_t)l * 2048 * NIN; dst = (bf16_t*)(f.ws + wo + WS_WINT);
            shp = (const float*)(f.ws + WS_ADA) + (size_t)l * 3 * 18432 + (size_t)3 * 2048; shd = (float*)(f.ws + WS_SHW) + (size_t)l * SHW_LAYER + SHW_WIN; shn = NINP; }
        else if (item < 1448) { const int it = item - 1352, j = it >> 5; nb = it & 31; kb = 0; K = 1024; Nsrc = 2048; kind = 1;
            src = p.in[I_WBR] + (size_t)(l * 3 + j) * 1024 * 2048; dst = (bf16_t*)(f.ws + wo + WS_WBRT) + (size_t)j * 2048 * 1024; }
        else { const int it = item - 1448; nb = it >> 1; kb = it & 1; K = 2048; Nsrc = 2048; kind = 1;
            src = p.in[I_WOUT] + (size_t)l * 2048 * 2048; dst = (bf16_t*)(f.ws + wo + WS_WOUTT); }
        const int nd = nb * 64 + f.lane;
        int scol;
        if (kind == 0) scol = ((nd >> 7) & 1) * 4096 + (nd >> 8) * 128 + (nd & 127);
        else if (kind == 1) scol = nd;
        else scol = win_src_col(nd);
        const int k0 = kb * 1024 + f.wid * 128;
        const float* sp0 = src + (size_t)k0 * Nsrc + (scol >= 0 ? scol : 0);
        bf16_t* dp = dst + (size_t)nd * K + k0;
        float dsh0 = 0.f, dsh1 = 0.f, dsh2 = 0.f;
#pragma unroll 1
        for (int kk = 0; kk < 128; kk += 64) {
            float v[64];
#pragma unroll
            for (int j = 0; j < 64; ++j) v[j] = sp0[(size_t)(kk + j) * Nsrc];
            if (scol < 0) {
#pragma unroll
                for (int j = 0; j < 64; ++j) v[j] = 0.f; }
            if (shp) { const float* s0 = shp + k0 + kk; const float* s1 = s0 + 9 * 2048; const float* s2 = s1 + 9 * 2048;
#pragma unroll
                for (int j = 0; j < 64; ++j) { dsh0 += v[j] * s0[j]; dsh1 += v[j] * s1[j]; dsh2 += v[j] * s2[j]; } }
#pragma unroll
            for (int q = 0; q < 8; ++q) {
                u32x4 w;
                w.x = cvt_pk_bf16(v[8 * q + 0], v[8 * q + 1]); w.y = cvt_pk_bf16(v[8 * q + 2], v[8 * q + 3]); w.z = cvt_pk_bf16(v[8 * q + 4], v[8 * q + 5]); w.w = cvt_pk_bf16(v[8 * q + 6], v[8 * q + 7]);
                *(u32x4*)(dp + kk + 8 * q) = w;
            }
        }
        if (shp && scol >= 0) { atomicAdd(shd + nd, dsh0); atomicAdd(shd + shn + nd, dsh1); atomicAdd(shd + 2 * shn + nd, dsh2); }
    }
}
constexpr int CONV_ITEMS = 1512;
__device__ __forceinline__ void convert_range(const Params& p, int l, int lo, int hi, int w, int nw, const Frame& f) {
#pragma unroll 1
    for (int item = lo + w; item < hi; item += nw) convert_item(p, l, item, f);
}
__device__ __forceinline__ void convert_first_set(const Params& p, int l, int w, int nw, const Frame& f) {
    convert_bias(p, l, w, nw, f);
    convert_range(p, l, 0, 256, w, nw, f); convert_range(p, l, 512, 640, w, nw, f);
    if (l != 0) convert_range(p, l, 1280, 1352, w, nw, f);
}
__device__ __forceinline__ void convert_fill(const Params& p, int l, int slot, const Frame& f) {
    if (f.G != 256) return;
    if (slot == 6) { if (f.bid >= 176) convert_range(p, l, 1352, 1512, f.bid - 176, 80, f); return; }
    if (f.bid < 128) return;
    const int w = f.bid - 128;
    if (slot == 0) convert_range(p, l, 768, l == 0 ? 1352 : 1280, w, 128, f);
    else if (slot == 1) convert_range(p, l, 256, 384, w, 128, f);
    else if (slot == 2) convert_range(p, l, 384, 512, w, 128, f);
    else if (slot == 3) { if (l == 0) phase_ada(p, 1, w, 128, f); }
    else if (slot == 4) convert_range(p, l, 640, 768, w, 128, f);
    else if (slot == 5 && l == 0) convert_first_set(p, 1, w, 128, f);
}
__device__ __forceinline__ void phase_convert(const Params& p, int l, const Frame& f) {
    if (f.G == 256) { if (l == 0) convert_first_set(p, 0, f.bid, f.G, f); }
    else { convert_bias(p, l, f.bid, f.G, f); convert_range(p, l, 0, CONV_ITEMS, f.bid, f.G, f); }
}

__device__ __forceinline__ void phase_final_norm(const Params& p, const Frame& f) {
    float* X = f.out + OUT_Y; const float* g = p.in[I_FNG]; const float* SS = (const float*)(f.ws + WS_SS) + (size_t)6 * MROWS;
    const size_t n = (size_t)MROWS * 512, stride = (size_t)f.G * NTHREADS;
    for (size_t i0 = (size_t)f.bid * NTHREADS + f.tid; i0 < n; i0 += 4 * stride) {
        f32x4 x[4]; float rs[4];
#pragma unroll
        for (int k = 0; k < 4; ++k) { const size_t i = i0 + k * stride; if (i < n) { x[k] = *(const f32x4*)(X + (i >> 9) * 2048 + (i & 511) * 4); rs[k] = SS[i >> 9]; } }
#pragma unroll
        for (int k = 0; k < 4; ++k) { const size_t i = i0 + k * stride; if (i < n) { const int c = (int)(i & 511) * 4;
            *(f32x4*)(X + (i >> 9) * 2048 + c) = x[k] * rsqrtf(rs[k] * (1.0f / 2048.0f) + EPS) * *(const f32x4*)(g + c); } }
    }
}

__device__ __forceinline__ void phase_merge(const Params& p, int l, const Frame& f) {
    const bf16_t* HS = (const bf16_t*)(f.ws + WS_HS); const bf16_t* PG = (const bf16_t*)(f.ws + WS_PG); bf16_t* YS = (bf16_t*)(f.ws + WS_YS);
    const float* hng = p.in[I_HNG] + (size_t)l * 3 * 128;
    for (int row = f.bid * NWAVES + f.wid; row < MROWS; row += f.G * NWAVES) {
        const int c0 = 16 * f.lane;
        u32x4 rf[3][2], rbk[3][2], rg[3][2];
#pragma unroll
        for (int mx = 0; mx < 3; ++mx) {
            const bf16_t* pf = HS + ((size_t)(mx * 2 + 0) * MROWS + row) * 1024 + c0;
            const bf16_t* pb = HS + ((size_t)(mx * 2 + 1) * MROWS + row) * 1024 + c0;
            const bf16_t* pgt = PG + (size_t)row * LDQ + mx * 1024 + c0;
            rf[mx][0] = *(const u32x4*)pf; rf[mx][1] = *(const u32x4*)(pf + 8); rbk[mx][0] = *(const u32x4*)pb; rbk[mx][1] = *(const u32x4*)(pb + 8);
            rg[mx][0] = *(const u32x4*)pgt; rg[mx][1] = *(const u32x4*)(pgt + 8);
        }
#pragma unroll
        for (int mx = 0; mx < 3; ++mx) {
            float a[8], b[8], s[16], gt[16];
            unpack8(rf[mx][0], a); unpack8(rbk[mx][0], b);
#pragma unroll
            for (int j = 0; j < 8; ++j) s[j] = a[j] + b[j];
            unpack8(rf[mx][1], a); unpack8(rbk[mx][1], b);
#pragma unroll
            for (int j = 0; j < 8; ++j) s[8 + j] = a[j] + b[j];
            unpack8(rg[mx][0], a); unpack8(rg[mx][1], b);
#pragma unroll
            for (int j = 0; j < 8; ++j) { gt[j] = a[j]; gt[8 + j] = b[j]; }
            float ss = 0.f;
#pragma unroll
            for (int j = 0; j < 16; ++j) ss += s[j] * s[j];
            ss += __shfl_xor(ss, 1); ss += __shfl_xor(ss, 2); ss += __shfl_xor(ss, 4);
            const float rs = rsqrtf(ss * (1.0f / 128.0f) + EPS);
            const float* hg = hng + mx * 128 + (c0 & 127);
            float o[8];
#pragma unroll
            for (int j = 0; j < 8; ++j) o[j] = s[j] * rs * hg[j] * gt[j];
            bf16_t* po = YS + ((size_t)mx * MROWS + row) * 1024 + c0;
            *(u32x4*)po = pack8(o);
#pragma unroll
            for (int j = 0; j < 8; ++j) o[j] = s[8 + j] * rs * hg[8 + j] * gt[8 + j];
            *(u32x4*)(po + 8) = pack8(o);
        }
    }
}

constexpr int PA = 144, PB = 80;
typedef short v4i16_t __attribute__((ext_vector_type(4)));
__device__ __forceinline__ bf16x8 rd_frag(const LAS bf16_t* X, int pitch, int row0, int k0, int lane) {
    return *(const LAS bf16x8*)(X + (row0 + (lane & 15)) * pitch + k0 + 8 * (lane >> 4));
}
__device__ __forceinline__ bf16x8 tr_frag(const LAS bf16_t* X, int pitch, int t0, int c0, int lane) {
    const LAS bf16_t* a = X + (t0 + 8 * (lane >> 4) + ((lane & 15) >> 2)) * pitch + c0 + 4 * (lane & 3);
    const v4i16_t lo = __builtin_amdgcn_ds_read_tr16_b64_v4i16((LAS v4i16_t*)a);
    const v4i16_t hi = __builtin_amdgcn_ds_read_tr16_b64_v4i16((LAS v4i16_t*)(a + 4 * pitch));
    bf16x8 f; f[0] = lo[0]; f[1] = lo[1]; f[2] = lo[2]; f[3] = lo[3]; f[4] = hi[0]; f[5] = hi[1]; f[6] = hi[2]; f[7] = hi[3];
    return f;
}

constexpr int PR_KN = 0, PR_V = 18432, PR_ASC = 36864, PR_KK = 69632, PR_QN = 86272, PR_T1 = 69632, PR_T2 = 90112, PR_GS = 110592, PR_BS = 111104,
              PR_TU = 111616, PR_A21 = 121856, PR_XT = 126976, PR_CW = 132096, PR_END = 136704,
              PR_AD = 36864, PR_A21S = 45056, PR_T22S = 50176, PR_XTS = 55296;
static_assert(PR_END <= LDS_BYTES - 64, "prep LDS map");
struct PrepLoads { u32x4 r[3][6]; float gb, ga; };
__device__ __forceinline__ void prep_issue_loads(PrepLoads& L, const bf16_t* PQ, const float* GT, int item, int tid, int lane, int wid) {
    const int gc = item >> 3, h = item & 7, row0 = gc * 64;
    const bool first = (gc < 64) ? ((gc & 3) == 0) : (((gc - 64) & 63) == 0);
    const bool last = (gc < 64) ? ((gc & 3) == 3) : (((gc - 64) & 63) == 63);
    const int i = tid >> 3, s = tid & 7, row = row0 + i;
    const bool okm = (i > 0) || !first, okp = (i < 63) || !last;
    const u32x4 z = {0u, 0u, 0u, 0u};
#pragma unroll
    for (int X = 0; X < 3; ++X) {
        const bf16_t* src = PQ + (size_t)row * LDQ + 3072 + X * 1024 + h * 128 + 8 * s;
        L.r[X][0] = okm ? *(const u32x4*)(src - LDQ) : z; L.r[X][1] = *(const u32x4*)src; L.r[X][2] = okp ? *(const u32x4*)(src + LDQ) : z;
        L.r[X][3] = okm ? *(const u32x4*)(src - LDQ + 64) : z; L.r[X][4] = *(const u32x4*)(src + 64); L.r[X][5] = okp ? *(const u32x4*)(src + LDQ + 64) : z;
    }
    L.gb = 0.f; L.ga = 0.f;
    if (wid < 2) { const int dir = wid, r2 = row0 + sp(lane, dir); L.gb = GT[(size_t)r2 * 64 + 32 + dir * 8 + h]; L.ga = GT[(size_t)r2 * 64 + 48 + dir * 8 + h]; }
}
__device__ __forceinline__ void phase_delta_prep(const Params& p, int l, const Frame& f) {
    LAS bf16_t* kn = (LAS bf16_t*)(f.lds + PR_KN); LAS bf16_t* vv = (LAS bf16_t*)(f.lds + PR_V); LAS bf16_t* qn = (LAS bf16_t*)(f.lds + PR_QN);
    LAS float* KK = (LAS float*)(f.lds + PR_KK); LAS float* Ad = (LAS float*)(f.lds + PR_AD);
    LAS bf16_t* A21s = (LAS bf16_t*)(f.lds + PR_A21S); LAS bf16_t* T22s = (LAS bf16_t*)(f.lds + PR_T22S); LAS bf16_t* XTs = (LAS bf16_t*)(f.lds + PR_XTS);
    LAS float* Gs = (LAS float*)(f.lds + PR_GS); LAS float* bs = (LAS float*)(f.lds + PR_BS);
    LAS bf16_t* T1 = (LAS bf16_t*)(f.lds + PR_T1); LAS bf16_t* T2 = (LAS bf16_t*)(f.lds + PR_T2);
    LAS bf16_t* TU = (LAS bf16_t*)(f.lds + PR_TU); LAS bf16_t* A21 = (LAS bf16_t*)(f.lds + PR_A21); LAS bf16_t* XT = (LAS bf16_t*)(f.lds + PR_XT);
    const bf16_t* PQ = (const bf16_t*)(f.ws + WS_PQ); const float* GT = (const float*)(f.ws + WS_GT);
    bf16_t* QN = (bf16_t*)(f.ws + WS_QN); bf16_t* KNg = (bf16_t*)(f.ws + WS_KT); bf16_t* U0T = (bf16_t*)(f.ws + WS_U0T); bf16_t* WKg = (bf16_t*)(f.ws + WS_WK);
    bf16_t* QKD = (bf16_t*)(f.ws + WS_QKD); float* GCH = (float*)(f.ws + WS_GCH);
    const float* convw = p.in[I_CONVW] + (size_t)l * 3 * 3072;
    const int wid = f.wid;
    PrepLoads L;
    if (f.bid < 192 * 8) prep_issue_loads(L, PQ, GT, f.bid, f.tid, f.lane, wid);
    LAS float* cw = (LAS float*)(f.lds + PR_CW);
    for (int i = f.tid; i < (PR_XTS + 5120 - PR_A21S) / 4; i += NTHREADS) ((LAS unsigned*)(f.lds + PR_A21S))[i] = 0u;
    for (int i = f.tid; i < 10240 / 4; i += NTHREADS) ((LAS unsigned*)(f.lds + PR_TU))[i] = 0u;
    int hcur = -1;
#pragma unroll 1
    for (int item = f.bid; item < 192 * 8; item += f.G) {
        const int gc = item >> 3, h = item & 7, row0 = gc * 64, ch = gc * 8 + h;
        int tid = f.tid; asm volatile("" : "+v"(tid));
        const int lane = tid & 63;
        __syncthreads();
        if (h != hcur) {
            for (int i = f.tid; i < 3 * 384; i += NTHREADS) { const int tap = i / 384, c = i % 384; cw[i] = convw[tap * 3072 + (c >> 7) * 1024 + h * 128 + (c & 127)]; }
            hcur = h;
            __syncthreads();
        }
        {
            const int i = tid >> 3, s = tid & 7, row = row0 + i;
#pragma unroll
            for (int X = 0; X < 3; ++X) {
                const int cb = X * 1024 + h * 128 + 8 * s;
                float o1[8], o2[8];
                {
                    float xm[8], x0[8], xp[8];
                    unpack8(L.r[X][0], xm); unpack8(L.r[X][1], x0); unpack8(L.r[X][2], xp);
                    const LAS float* w = cw + X * 128 + 8 * s;
#pragma unroll
                    for (int j = 0; j < 8; ++j) o1[j] = fsilu(xm[j] * w[j] + x0[j] * w[384 + j] + xp[j] * w[768 + j]);
                    unpack8(L.r[X][3], xm); unpack8(L.r[X][4], x0); unpack8(L.r[X][5], xp);
#pragma unroll
                    for (int j = 0; j < 8; ++j) o2[j] = fsilu(xm[j] * w[64 + j] + x0[j] * w[384 + 64 + j] + xp[j] * w[768 + 64 + j]);
                }
                if (X < 2) {
                    float ss = 0.f;
#pragma unroll
                    for (int j = 0; j < 8; ++j) ss += o1[j] * o1[j] + o2[j] * o2[j];
                    ss += __shfl_xor(ss, 1); ss += __shfl_xor(ss, 2); ss += __shfl_xor(ss, 4);
                    const float scl = rsqrtf(ss + EPS) * (X == 0 ? QSCALE : 1.0f);
#pragma unroll
                    for (int j = 0; j < 8; ++j) { o1[j] *= scl; o2[j] *= scl; }
                }
                const u32x4 w1 = pack8(o1), w2 = pack8(o2);
                LAS bf16_t* T = (X == 0) ? qn : ((X == 1) ? kn : vv);
                *(LAS u32x4*)(T + i * PA + 8 * s) = w1; *(LAS u32x4*)(T + i * PA + 64 + 8 * s) = w2;
                if (X < 2) { bf16_t* g = ((X == 0) ? QN : KNg) + (size_t)row * 1024 + h * 128 + 8 * s; *(u32x4*)g = w1; *(u32x4*)(g + 64) = w2; }
            }
        }
        if (wid < 2) {
            const int dir = wid, i = sp(lane, dir);
            const float be = fsigmoid(L.gb);
            const float xa = L.ga + p.in[I_DTB][(l * 2 + dir) * 8 + h];
            const float spl = (xa > 20.f) ? xa : __logf(1.0f + __expf(xa));
            const float g = -__expf(p.in[I_ALOG][(l * 2 + dir) * 8 + h]) * spl;
            const float G = wave_scan_add(g, lane);
            Gs[dir * 64 + i] = G; bs[dir * 64 + i] = be;
            GCH[(size_t)(ch * 2 + dir) * 64 + i] = G;
        }
        if (item + f.G < 192 * 8) prep_issue_loads(L, PQ, GT, item + f.G, tid, lane, wid);
        __syncthreads();
#pragma unroll
        for (int t2 = 0; t2 < 2; ++t2) {
            const int tt = 2 * wid + t2, tm = tt >> 2, tn = tt & 3;
            f32x4 akk = {0.f, 0.f, 0.f, 0.f}, aqk = akk;
#pragma unroll
            for (int ks = 0; ks < 4; ++ks) {
                const bf16x8 a = rd_frag(kn, PA, 16 * tm, 32 * ks, lane);
                akk = mfma16(a, rd_frag(kn, PA, 16 * tn, 32 * ks, lane), akk);
                aqk = mfma16(a, rd_frag(qn, PA, 16 * tn, 32 * ks, lane), aqk);
            }
            const int r0 = 16 * tm + 4 * (lane >> 4), cc = 16 * tn + (lane & 15);
#pragma unroll
            for (int r = 0; r < 4; ++r) KK[(r0 + r) * 65 + cc] = akk[r];
#pragma unroll
            for (int dir = 0; dir < 2; ++dir) {
                const float Gi = Gs[dir * 64 + cc]; const int pi = sp(cc, dir);
                f32x4 v;
#pragma unroll
                for (int r = 0; r < 4; ++r) { const int j = r0 + r; const float e = aqk[r] * __expf(fminf(Gi - Gs[dir * 64 + j], 0.f)); v[r] = (sp(j, dir) <= pi) ? e : 0.f; }
                *(u32x2*)(QKD + (size_t)(ch * 2 + dir) * 4096 + cc * 64 + r0) = pack4(v);
            }
        }
        __syncthreads();
#pragma unroll 4
        for (int it = 0; it < 8; ++it) {
            const int e = tid + 512 * it, dir = e >> 11, kk = (e >> 6) & 31, sl = e & 63;
            const int pp = (sl < kk) ? kk : 63 - kk, p2 = (sl < kk) ? sl : sl - kk;
            if (p2 < pp) {
                const int i = sp(pp, dir), j = sp(p2, dir);
                const float a = bs[dir * 64 + i] * KK[i * 65 + j] * __expf(fminf(Gs[dir * 64 + i] - Gs[dir * 64 + j], 0.f));
                if (pp >= 32 && p2 < 32) A21[(dir * 32 + (pp - 32)) * 40 + p2] = f2bf(a);
                else if ((pp >> 4) == (p2 >> 4)) Ad[((dir * 4 + (pp >> 4)) * 16 + (pp & 15)) * 16 + (p2 & 15)] = a;
                else A21s[((dir * 2 + (pp >> 5)) * 16 + (pp & 15)) * 40 + (p2 & 15)] = f2bf(a);
            }
        }
        __syncthreads();
        {
            const int dir = wid >> 2, d16 = wid & 3, b = d16 >> 1, half = d16 & 1, c = lane & 15;
            const LAS float* A = Ad + (dir * 4 + d16) * 256;
            const int jn = sp(16 * d16 + c, dir); const float bj = bs[dir * 64 + jn], bg = bj * __expf(Gs[dir * 64 + jn]);
            LAS bf16_t* t1p = T1 + (dir * 64 + 16 * d16) * PB + jn; LAS bf16_t* t2p = T2 + (dir * 64 + 16 * d16) * PB + jn;
            LAS bf16_t* tup = TU + ((dir * 2 + b) * 32 + 16 * half) * 40 + 16 * half + c;
            LAS bf16_t* t22p = T22s + ((dir * 2 + b) * 16) * 40 + c;
            const int bc = d16 + (lane >> 4); const int jz = sp((16 * bc + c) & 63, dir);
            LAS bf16_t* z1p = T1 + (dir * 64 + 16 * d16) * PB + jz; LAS bf16_t* z2p = T2 + (dir * 64 + 16 * d16) * PB + jz;
            const bool wl = lane < 16, zl = (lane >= 16) && (bc <= 3);
            float ar[16];
#pragma unroll
            for (int r = 0; r < 16; ++r) ar[r] = A[r * 16 + c];
            float t[16];
#pragma unroll
            for (int r = 0; r < 16; ++r) {
                float ac[4] = {(r == c) ? 1.f : 0.f, 0.f, 0.f, 0.f};
#pragma unroll
                for (int j = 0; j < r; ++j) {
                    const float aj = __builtin_bit_cast(float, __builtin_amdgcn_readlane(__builtin_bit_cast(int, ar[r]), j));
                    ac[j & 3] -= aj * t[j];
                }
                const float acc = (ac[0] + ac[1]) + (ac[2] + ac[3]);
                t[r] = acc;
                if (wl) { t1p[r * PB] = f2bf(acc * bj); t2p[r * PB] = f2bf(acc * bg); tup[r * 40] = f2bf(acc); if (half) t22p[r * 40] = f2bf(acc); }
                if (zl) { z1p[r * PB] = (bf16_t)0; z2p[r * PB] = (bf16_t)0; }
            }
        }
        __syncthreads();
        if (wid < 4) {
            const int dir = wid >> 1, b = wid & 1;
            const LAS bf16_t* a21s = A21s + (dir * 2 + b) * 16 * 40; const LAS bf16_t* t22s = T22s + (dir * 2 + b) * 16 * 40;
            LAS bf16_t* tub = TU + (dir * 2 + b) * 32 * 40; LAS bf16_t* xts = XTs + (dir * 2 + b) * 16 * 40;
            f32x4 x = {0.f, 0.f, 0.f, 0.f};
            x = mfma16(rd_frag(a21s, 40, 0, 0, lane), tr_frag(tub, 40, 0, 0, lane), x);
            *(LAS u32x2*)(xts + (lane & 15) * 40 + 4 * (lane >> 4)) = pack4(x);
            f32x4 y = {0.f, 0.f, 0.f, 0.f};
            y = mfma16(rd_frag(t22s, 40, 0, 0, lane), rd_frag(xts, 40, 0, 0, lane), y);
            const int n = lane & 15, m0 = 4 * (lane >> 4);
            const int jn = sp(32 * b + n, dir); const float bj = bs[dir * 64 + jn], bg = bj * __expf(Gs[dir * 64 + jn]);
#pragma unroll
            for (int r = 0; r < 4; ++r) {
                const int pp = 32 * b + 16 + m0 + r;
                tub[(16 + m0 + r) * 40 + n] = f2bf(-y[r]);
                T1[(dir * 64 + pp) * PB + jn] = f2bf(-y[r] * bj); T2[(dir * 64 + pp) * PB + jn] = f2bf(-y[r] * bg);
            }
        }
        __syncthreads();
        if (wid < 2) {
            const int dir = wid;
            const LAS bf16_t* a21 = A21 + dir * 32 * 40; const LAS bf16_t* tu11 = TU + (dir * 2) * 32 * 40; LAS bf16_t* xt = XT + dir * 32 * 40;
            const LAS bf16_t* tu22 = TU + (dir * 2 + 1) * 32 * 40;
#pragma unroll
            for (int tm = 0; tm < 2; ++tm)
#pragma unroll
                for (int tn = 0; tn < 2; ++tn) {
                    f32x4 x = {0.f, 0.f, 0.f, 0.f};
                    x = mfma16(rd_frag(a21, 40, 16 * tm, 0, lane), tr_frag(tu11, 40, 0, 16 * tn, lane), x);
                    *(LAS u32x2*)(xt + (16 * tn + (lane & 15)) * 40 + 16 * tm + 4 * (lane >> 4)) = pack4(x);
                }
#pragma unroll
            for (int tm = 0; tm < 2; ++tm)
#pragma unroll
                for (int tn = 0; tn < 2; ++tn) {
                    f32x4 y = {0.f, 0.f, 0.f, 0.f};
                    y = mfma16(rd_frag(tu22, 40, 16 * tm, 0, lane), rd_frag(xt, 40, 16 * tn, 0, lane), y);
                    const int jn = sp(16 * tn + (lane & 15), dir); const float bj = bs[dir * 64 + jn], bg = bj * __expf(Gs[dir * 64 + jn]);
                    const int pp0 = 32 + 16 * tm + 4 * (lane >> 4);
#pragma unroll
                    for (int r = 0; r < 4; ++r) { T1[(dir * 64 + pp0 + r) * PB + jn] = f2bf(-y[r] * bj); T2[(dir * 64 + pp0 + r) * PB + jn] = f2bf(-y[r] * bg); }
                }
        }
        __syncthreads();
        {
            const int dir = wid >> 2, sub = wid & 3;
            bf16_t* u0 = U0T + (size_t)(ch * 2 + dir) * 8192; bf16_t* wk = WKg + (size_t)(ch * 2 + dir) * 8192;
            const bf16x8 a0 = rd_frag(T1 + dir * 64 * PB, PB, 16 * sub, 0, lane), a1 = rd_frag(T1 + dir * 64 * PB, PB, 16 * sub, 32, lane);
            const bf16x8 b0 = rd_frag(T2 + dir * 64 * PB, PB, 16 * sub, 0, lane), b1 = rd_frag(T2 + dir * 64 * PB, PB, 16 * sub, 32, lane);
#pragma unroll 2
            for (int tn = 0; tn < 8; ++tn) {
                f32x4 a = {0.f, 0.f, 0.f, 0.f}, b = a;
                a = mfma16(a0, tr_frag(vv, PA, 0, 16 * tn, lane), a); a = mfma16(a1, tr_frag(vv, PA, 32, 16 * tn, lane), a);
                {
                    const int pp0 = 16 * sub + 4 * (lane >> 4);
                    f32x4 ar; ar[0] = a[3]; ar[1] = a[2]; ar[2] = a[1]; ar[3] = a[0];
                    *(u32x2*)(u0 + (16 * tn + (lane & 15)) * 64 + (dir ? 60 - pp0 : pp0)) = pack4(dir ? ar : a);
                }
                b = mfma16(tr_frag(kn, PA, 0, 16 * tn, lane), b0, b); b = mfma16(tr_frag(kn, PA, 32, 16 * tn, lane), b1, b);
                *(u32x2*)(wk + sp(16 * sub + (lane & 15), dir) * 128 + 16 * tn + 4 * (lane >> 4)) = pack4(b);
            }
        }
    }
}

struct SeqInfo { int rowbase, NC, b; bool samp; };
__device__ __forceinline__ SeqInfo seq_info(int seq) { SeqInfo s; s.samp = seq >= 16; s.NC = s.samp ? 64 : 4; s.b = s.samp ? seq - 16 : seq; s.rowbase = s.samp ? 4096 + (seq - 16) * 4096 : seq * 256; return s; }
__device__ __forceinline__ size_t state_index(int b, int l, int dir, int h) { return (size_t)(((b * 2 + l) * 2 + dir) * 8 + h); }

__device__ __forceinline__ void state_load(f32x4 (&acc)[4], const float* src, int eh, LAS bf16_t* ST, const Frame& f) {
    const int d0 = 16 * f.wid + 4 * (f.lane >> 4), e0 = f.lane & 15;
#pragma unroll
    for (int te = 0; te < 4; ++te) {
        f32x4 v = {0.f, 0.f, 0.f, 0.f};
        if (src) {
#pragma unroll
            for (int r = 0; r < 4; ++r) v[r] = src[(size_t)(d0 + r) * 128 + 64 * eh + 16 * te + e0]; }
        acc[te] = v;
        *(LAS u32x2*)(ST + (16 * te + e0) * PA + d0) = pack4(v);
    }
}
__device__ __forceinline__ void state_store(const f32x4 (&acc)[4], float* dst, int eh, const Frame& f) {
    const int d0 = 16 * f.wid + 4 * (f.lane >> 4), e0 = f.lane & 15;
#pragma unroll
    for (int te = 0; te < 4; ++te)
#pragma unroll
        for (int r = 0; r < 4; ++r) dst[(size_t)(d0 + r) * 128 + 64 * eh + 16 * te + e0] = acc[te][r];
}

constexpr int SC_Q = 0, SC_K = 18432, SC_K2 = 36864, SC_V = 55296, SC_P = 65536, SC_ST = 75776, SC_VEC = 94208;

__device__ __forceinline__ void ret_item(const Params& p, int l, int seq, int h, int dir, int eh, unsigned* qnext, const Frame& f) {
    LAS bf16_t* q = (LAS bf16_t*)(f.lds + SC_Q); LAS bf16_t* ke = (LAS bf16_t*)(f.lds + SC_K); LAS bf16_t* vv = (LAS bf16_t*)(f.lds + SC_V);
    LAS bf16_t* P = (LAS bf16_t*)(f.lds + SC_P); LAS bf16_t* ST = (LAS bf16_t*)(f.lds + SC_ST);
    const bf16_t* PQ = (const bf16_t*)(f.ws + WS_PQ); const float* rope = (const float*)(f.ws + WS_ROPE);
    bf16_t* HS = (bf16_t*)(f.ws + WS_HS) + (size_t)(2 * 2 + dir) * MROWS * 1024;
    const SeqInfo si = seq_info(seq);
    const int tid = f.tid, lane = f.lane, wid = f.wid;
    const float lg = p.in[I_LGAM][(l * 2 + dir) * 8 + h];
    const size_t sidx = state_index(si.b, l, dir, h);
    f32x4 accS[4];
    __syncthreads();
    state_load(accS, si.samp ? p.in[I_SR] + sidx * 16384 : nullptr, eh, ST, f);
    const float cdec = __expf(lg * 64.0f);
    const int si_i = tid >> 3, si_s = tid & 7;
    u32x4 rq1, rq2, rk1, rk2, rv; f32x4 rcs[4];
    const int rope_f0 = (si_s < 4) ? 8 * si_s : 8 * si_s - 32;
    {
        const int cn = dir ? si.NC - 1 : 0;
        { const f32x4* cs4 = (const f32x4*)(rope + (size_t)(((si_s < 4) ? cn : si_i) * 32 + rope_f0) * 2); rcs[0] = cs4[0]; rcs[1] = cs4[1]; rcs[2] = cs4[2]; rcs[3] = cs4[3]; }
        const bf16_t* src = PQ + (size_t)(si.rowbase + 64 * cn + si_i) * LDQ + h * 128 + 8 * si_s;
        rq1 = *(const u32x4*)(src + 6144); rq2 = *(const u32x4*)(src + 6144 + 64); rk1 = *(const u32x4*)(src + 7168); rk2 = *(const u32x4*)(src + 7168 + 64);
        rv = *(const u32x4*)(src + 8192 + 64 * eh);
    }
    int nxt;
#pragma unroll 1
    for (int n = 0; n < si.NC; ++n) {
        const int cn = dir ? si.NC - 1 - n : n, row0 = si.rowbase + 64 * cn;
        {
            const int i = si_i, s = si_s;
            float q1[8], q2[8], k1[8], k2[8];
            unpack8(rq1, q1); unpack8(rq2, q2); unpack8(rk1, k1); unpack8(rk2, k2);
            const float kes = __expf(lg * (float)(63 - sp(i, dir)));
            if (si.samp) {
#pragma unroll
                for (int j = 0; j < 8; ++j) { const float c = rcs[j >> 1][2 * (j & 1)], sn = rcs[j >> 1][2 * (j & 1) + 1];
                    const float a = q1[j] * c - q2[j] * sn, b = q2[j] * c + q1[j] * sn; q1[j] = a; q2[j] = b;
                    const float a2 = k1[j] * c - k2[j] * sn, b2 = k2[j] * c + k1[j] * sn; k1[j] = a2; k2[j] = b2; }
            }
#pragma unroll
            for (int j = 0; j < 8; ++j) { q1[j] *= QSCALE; q2[j] *= QSCALE; k1[j] *= kes; k2[j] *= kes; }
            *(LAS u32x4*)(q + i * PA + 8 * s) = pack8(q1); *(LAS u32x4*)(q + i * PA + 64 + 8 * s) = pack8(q2);
            *(LAS u32x4*)(ke + i * PA + 8 * s) = pack8(k1); *(LAS u32x4*)(ke + i * PA + 64 + 8 * s) = pack8(k2);
            *(LAS u32x4*)(vv + i * PB + 8 * s) = rv;
        }
        if (n + 1 < si.NC) {
            const int cn2 = dir ? si.NC - 2 - n : n + 1;
            { const f32x4* cs4 = (const f32x4*)(rope + (size_t)(((si_s < 4) ? cn2 : si_i) * 32 + rope_f0) * 2); rcs[0] = cs4[0]; rcs[1] = cs4[1]; rcs[2] = cs4[2]; rcs[3] = cs4[3]; }
            const bf16_t* src = PQ + (size_t)(si.rowbase + 64 * cn2 + si_i) * LDQ + h * 128 + 8 * si_s;
            rq1 = *(const u32x4*)(src + 6144); rq2 = *(const u32x4*)(src + 6144 + 64); rk1 = *(const u32x4*)(src + 7168); rk2 = *(const u32x4*)(src + 7168 + 64);
            rv = *(const u32x4*)(src + 8192 + 64 * eh);
        }
        if (n == si.NC - 1 && f.tid == 0) { unsigned zo = 0; asm volatile("" : "+v"(zo)); nxt = (int)__hip_atomic_fetch_add(qnext + zo, 1u, __ATOMIC_RELAXED, __HIP_MEMORY_SCOPE_AGENT); }
        __syncthreads();
#pragma unroll
        for (int t2 = 0; t2 < 2; ++t2) {
            const int tt = 2 * wid + t2, tm = tt >> 2, tn = tt & 3;
            f32x4 a = {0.f, 0.f, 0.f, 0.f};
#pragma unroll
            for (int ks = 0; ks < 4; ++ks) a = mfma16(rd_frag(ke, PA, 16 * tm, 32 * ks, lane), rd_frag(q, PA, 16 * tn, 32 * ks, lane), a);
            const int j0 = 16 * tm + 4 * (lane >> 4), i = 16 * tn + (lane & 15), pi = sp(i, dir);
            const float rsc = __expf(lg * (float)(pi - 63));
            f32x4 v;
#pragma unroll
            for (int r = 0; r < 4; ++r) v[r] = (sp(j0 + r, dir) <= pi) ? a[r] * rsc : 0.f;
            *(LAS u32x2*)(P + i * PB + j0) = pack4(v);
        }
        const int te = wid >> 1, ti0 = 2 * (wid & 1);
        f32x4 accO[2] = {{0.f, 0.f, 0.f, 0.f}, {0.f, 0.f, 0.f, 0.f}};
#pragma unroll
        for (int ks = 0; ks < 4; ++ks) {
            const bf16x8 a = rd_frag(ST, PA, 16 * te, 32 * ks, lane);
            accO[0] = mfma16(a, rd_frag(q, PA, 16 * ti0, 32 * ks, lane), accO[0]);
            accO[1] = mfma16(a, rd_frag(q, PA, 16 * ti0 + 16, 32 * ks, lane), accO[1]);
        }
        accO[0] *= __expf(lg * (float)(sp(16 * ti0 + (lane & 15), dir) + 1));
        accO[1] *= __expf(lg * (float)(sp(16 * ti0 + 16 + (lane & 15), dir) + 1));
        __syncthreads();
#pragma unroll
        for (int ks = 0; ks < 2; ++ks) {
            const bf16x8 a = tr_frag(vv, PB, 32 * ks, 16 * te, lane);
            accO[0] = mfma16(a, rd_frag(P, PB, 16 * ti0, 32 * ks, lane), accO[0]);
            accO[1] = mfma16(a, rd_frag(P, PB, 16 * ti0 + 16, 32 * ks, lane), accO[1]);
        }
#pragma unroll
        for (int t = 0; t < 2; ++t)
            *(u32x2*)(HS + (size_t)(row0 + 16 * (ti0 + t) + (lane & 15)) * 1024 + h * 128 + 64 * eh + 16 * te + 4 * (lane >> 4)) = pack4(accO[t]);
        {
            const bf16x8 a0 = tr_frag(ke, PA, 0, 16 * wid, lane), a1 = tr_frag(ke, PA, 32, 16 * wid, lane);
#pragma unroll
            for (int t = 0; t < 4; ++t) {
                accS[t] = mfma16(a0, tr_frag(vv, PB, 0, 16 * t, lane), accS[t] * cdec);
                accS[t] = mfma16(a1, tr_frag(vv, PB, 32, 16 * t, lane), accS[t]);
                *(LAS u32x2*)(ST + (16 * t + (lane & 15)) * PA + 16 * wid + 4 * (lane >> 4)) = pack4(accS[t]);
            }
        }
        __syncthreads();
    }
    if (!si.samp) state_store(accS, f.out + OUT_RS + sidx * 16384, eh, f);
    if (f.tid == 0) *(volatile LAS int*)(f.lds + LDS_BYTES - 128) = nxt;
}

__device__ __forceinline__ void mlstm_item(const Params& p, int l, int seq, int h, int dir, int eh, unsigned* qnext, const Frame& f) {
    LAS bf16_t* q = (LAS bf16_t*)(f.lds + SC_Q); LAS bf16_t* k = (LAS bf16_t*)(f.lds + SC_K); LAS bf16_t* kw = (LAS bf16_t*)(f.lds + SC_K2);
    LAS bf16_t* vv = (LAS bf16_t*)(f.lds + SC_V); LAS bf16_t* P = (LAS bf16_t*)(f.lds + SC_P); LAS bf16_t* CT = (LAS bf16_t*)(f.lds + SC_ST);
    LAS float* vec = (LAS float*)(f.lds + SC_VEC);
    LAS float* va = vec, *vr = vec + 64, *vwp = vec + 128, *vem = vec + 192, *vwt = vec + 256, *vqn = vec + 320, *vdd = vec + 384, *nvec = vec + 448, *scv = vec + 576;
    const bf16_t* PQ = (const bf16_t*)(f.ws + WS_PQ); const float* GT = (const float*)(f.ws + WS_GT);
    bf16_t* HS = (bf16_t*)(f.ws + WS_HS) + (size_t)(0 * 2 + dir) * MROWS * 1024;
    const SeqInfo si = seq_info(seq);
    const int tid = f.tid, lane = f.lane, wid = f.wid;
    const float fbias = p.in[I_FBIAS][(l * 2 + dir) * 8 + h];
    const size_t sidx = state_index(si.b, l, dir, h);
    f32x4 accC[4], accN;
    __syncthreads();
    state_load(accC, si.samp ? p.in[I_SC] + sidx * 16384 : nullptr, eh, CT, f);
    {
        const int d0 = 16 * wid + 4 * (lane >> 4);
#pragma unroll
        for (int r = 0; r < 4; ++r) accN[r] = si.samp ? p.in[I_SN][sidx * 128 + d0 + r] : 0.f;
        if ((lane & 15) == 0) {
#pragma unroll
            for (int r = 0; r < 4; ++r) nvec[d0 + r] = accN[r]; }
    }
    float m_prev = si.samp ? p.in[I_SM][sidx] : 0.f;
    const int si_i = tid >> 3, si_s = tid & 7;
    u32x4 rq1, rq2, rk1, rk2, rv; float rig = 0.f, rfp = 0.f;
    {
        const int cn = dir ? si.NC - 1 : 0, row0 = si.rowbase + 64 * cn;
        const bf16_t* src = PQ + (size_t)(row0 + si_i) * LDQ + h * 128 + 8 * si_s;
        rq1 = *(const u32x4*)(src); rq2 = *(const u32x4*)(src + 64); rk1 = *(const u32x4*)(src + 1024); rk2 = *(const u32x4*)(src + 1024 + 64);
        rv = *(const u32x4*)(src + 2048 + 64 * eh);
        if (wid == 0) { const size_t row = (size_t)(row0 + sp(lane, dir)); rig = GT[row * 64 + dir * 8 + h]; rfp = GT[row * 64 + 16 + dir * 8 + h]; }
    }
    bf16x8 ones;
#pragma unroll
    for (int j = 0; j < 8; ++j) ones[j] = (short)0x3F80;
    int nxt;
#pragma unroll 1
    for (int n = 0; n < si.NC; ++n) {
        const int cn = dir ? si.NC - 1 - n : n, row0 = si.rowbase + 64 * cn;
#pragma unroll 1
        for (int rep = 0; rep < ((PROBE_SEG == 4) ? 2 : 1); ++rep)
        if (wid == 0) {
            const int i = sp(lane, dir);
            const float ig = rig, fp = rfp + fbias;
            const float lf = fminf(fp, 0.f) - __logf(1.0f + __expf(-fabsf(fp)));
            const float b = wave_scan_add(lf, lane), a = ig - b, pm = wave_scan_max(a, lane);
            const float bL = __shfl(b, 63), pmL = __shfl(pm, 63);
            const float mx = fmaxf(m_prev, pm);
            va[i] = a; vr[i] = -mx; vwp[i] = __expf(m_prev - mx); vem[i] = __expf(-(b + mx));
            const float m_new = bL + fmaxf(m_prev, pmL);
            vwt[i] = __expf(bL + a - m_new);
            if (lane == 0) { scv[0] = __expf(bL + m_prev - m_new); scv[1] = m_new; }
        }
#pragma unroll 1
        for (int rep = 0; rep < ((PROBE_SEG == 3) ? 2 : 1); ++rep)
        {
            const int i = si_i, s = si_s;
            float k1[8], k2[8];
            unpack8(rk1, k1); unpack8(rk2, k2);
#pragma unroll
            for (int j = 0; j < 8; ++j) { k1[j] *= QSCALE; k2[j] *= QSCALE; }
            *(LAS u32x4*)(q + i * PA + 8 * s) = rq1; *(LAS u32x4*)(q + i * PA + 64 + 8 * s) = rq2;
            *(LAS u32x4*)(k + i * PA + 8 * s) = pack8(k1); *(LAS u32x4*)(k + i * PA + 64 + 8 * s) = pack8(k2);
            *(LAS u32x4*)(vv + i * PB + 8 * s) = rv;
        }
        if (n + 1 < si.NC) {
            const int cn2 = dir ? si.NC - 2 - n : n + 1, row2 = si.rowbase + 64 * cn2;
            const bf16_t* src = PQ + (size_t)(row2 + si_i) * LDQ + h * 128 + 8 * si_s;
            rq1 = *(const u32x4*)(src); rq2 = *(const u32x4*)(src + 64); rk1 = *(const u32x4*)(src + 1024); rk2 = *(const u32x4*)(src + 1024 + 64);
            rv = *(const u32x4*)(src + 2048 + 64 * eh);
            if (wid == 0) { const size_t row = (size_t)(row2 + sp(lane, dir)); rig = GT[row * 64 + dir * 8 + h]; rfp = GT[row * 64 + 16 + dir * 8 + h]; }
        }
        if (n == si.NC - 1 && f.tid == 0) { unsigned zo = 0; asm volatile("" : "+v"(zo)); nxt = (int)__hip_atomic_fetch_add(qnext + zo, 1u, __ATOMIC_RELAXED, __HIP_MEMORY_SCOPE_AGENT); }
        __syncthreads();
#pragma unroll 1
        for (int rep = 0; rep < ((PROBE_SEG == 1) ? 2 : 1); ++rep)
#pragma unroll
        for (int t2 = 0; t2 < 2; ++t2) {
            const int tt = 2 * wid + t2, tm = tt >> 2, tn = tt & 3;
            f32x4 a = {0.f, 0.f, 0.f, 0.f};
#pragma unroll
            for (int ks = 0; ks < 4; ++ks) a = mfma16(rd_frag(k, PA, 16 * tm, 32 * ks, lane), rd_frag(q, PA, 16 * tn, 32 * ks, lane), a);
            const int j0 = 16 * tm + 4 * (lane >> 4), i = 16 * tn + (lane & 15), pi = sp(i, dir);
            const float ri = vr[i];
            f32x4 v;
#pragma unroll
            for (int r = 0; r < 4; ++r) { const float e = a[r] * __expf(fminf(va[j0 + r] + ri, 0.f)); v[r] = (sp(j0 + r, dir) <= pi) ? e : 0.f; }
            *(LAS u32x2*)(P + i * PB + j0) = pack4(v);
        }
        const int te = wid >> 1, ti0 = 2 * (wid & 1);
        f32x4 accO[2] = {{0.f, 0.f, 0.f, 0.f}, {0.f, 0.f, 0.f, 0.f}};
#pragma unroll 1
        for (int rep = 0; rep < ((PROBE_SEG == 2) ? 2 : 1); ++rep) { accO[0] = (f32x4){0.f, 0.f, 0.f, 0.f}; accO[1] = accO[0]; asm volatile("" : "+v"(accO[0]), "+v"(accO[1]));
#pragma unroll
        for (int ks = 0; ks < 4; ++ks) {
            const bf16x8 a = rd_frag(CT, PA, 16 * te, 32 * ks, lane);
            accO[0] = mfma16(a, rd_frag(q, PA, 16 * ti0, 32 * ks, lane), accO[0]);
            accO[1] = mfma16(a, rd_frag(q, PA, 16 * ti0 + 16, 32 * ks, lane), accO[1]);
        }
        }
        accO[0] *= vwp[16 * ti0 + (lane & 15)];
        accO[1] *= vwp[16 * ti0 + 16 + (lane & 15)];
        {
            const int i = tid >> 3, s = tid & 7; float sum = 0.f;
            float x0[8], x1[8];
            unpack8(*(const LAS u32x4*)(q + i * PA + 16 * s), x0); unpack8(*(const LAS u32x4*)(q + i * PA + 16 * s + 8), x1);
#pragma unroll
            for (int c = 0; c < 8; ++c) sum += x0[c] * nvec[16 * s + c] + x1[c] * nvec[16 * s + 8 + c];
            sum += __shfl_xor(sum, 1); sum += __shfl_xor(sum, 2); sum += __shfl_xor(sum, 4);
            if (s == 0) vqn[i] = sum;
        }
        __syncthreads();
#pragma unroll
        for (int ks = 0; ks < 2; ++ks) {
            const bf16x8 a = tr_frag(vv, PB, 32 * ks, 16 * te, lane);
            accO[0] = mfma16(a, rd_frag(P, PB, 16 * ti0, 32 * ks, lane), accO[0]);
            accO[1] = mfma16(a, rd_frag(P, PB, 16 * ti0 + 16, 32 * ks, lane), accO[1]);
        }
        {
            const int i = tid >> 3, s = tid & 7; float x0[8];
            unpack8(*(const LAS u32x4*)(P + i * PB + 8 * s), x0);
            float sum = ((x0[0] + x0[1]) + (x0[2] + x0[3])) + ((x0[4] + x0[5]) + (x0[6] + x0[7]));
            sum += __shfl_xor(sum, 1); sum += __shfl_xor(sum, 2); sum += __shfl_xor(sum, 4);
            if (s == 0) { const float den = vwp[i] * vqn[i] + sum; vdd[i] = fmaxf(fabsf(den), vem[i]); }
        }
        const float ws = scv[0];
        {
            bf16x8 a0 = tr_frag(k, PA, 0, 16 * wid, lane), a1 = tr_frag(k, PA, 32, 16 * wid, lane);
            {
                const int j0 = 8 * (lane >> 4);
                const f32x4 wa = *(const LAS f32x4*)(vwt + j0), wb = *(const LAS f32x4*)(vwt + j0 + 4), wc2 = *(const LAS f32x4*)(vwt + 32 + j0), wd = *(const LAS f32x4*)(vwt + 32 + j0 + 4);
                u32x4 u0 = __builtin_bit_cast(u32x4, a0), u1 = __builtin_bit_cast(u32x4, a1);
                u0.x = cvt_pk_bf16(bflo(u0.x) * wa[0], bfhi(u0.x) * wa[1]); u0.y = cvt_pk_bf16(bflo(u0.y) * wa[2], bfhi(u0.y) * wa[3]);
                u0.z = cvt_pk_bf16(bflo(u0.z) * wb[0], bfhi(u0.z) * wb[1]); u0.w = cvt_pk_bf16(bflo(u0.w) * wb[2], bfhi(u0.w) * wb[3]);
                u1.x = cvt_pk_bf16(bflo(u1.x) * wc2[0], bfhi(u1.x) * wc2[1]); u1.y = cvt_pk_bf16(bflo(u1.y) * wc2[2], bfhi(u1.y) * wc2[3]);
                u1.z = cvt_pk_bf16(bflo(u1.z) * wd[0], bfhi(u1.z) * wd[1]); u1.w = cvt_pk_bf16(bflo(u1.w) * wd[2], bfhi(u1.w) * wd[3]);
                a0 = __builtin_bit_cast(bf16x8, u0); a1 = __builtin_bit_cast(bf16x8, u1);
            }
            accN = mfma16(a0, ones, accN * ws); accN = mfma16(a1, ones, accN);
#pragma unroll
            for (int t = 0; t < 4; ++t) {
                accC[t] = mfma16(a0, tr_frag(vv, PB, 0, 16 * t, lane), accC[t] * ws);
                accC[t] = mfma16(a1, tr_frag(vv, PB, 32, 16 * t, lane), accC[t]);
            }
        }
        m_prev = scv[1];
        __syncthreads();
#pragma unroll
        for (int t = 0; t < 2; ++t) {
            const int i = 16 * (ti0 + t) + (lane & 15);
            const float inv = 1.0f / vdd[i];
            *(u32x2*)(HS + (size_t)(row0 + i) * 1024 + h * 128 + 64 * eh + 16 * te + 4 * (lane >> 4)) = pack4(accO[t] * inv);
        }
#pragma unroll
        for (int t = 0; t < 4; ++t) *(LAS u32x2*)(CT + (16 * t + (lane & 15)) * PA + 16 * wid + 4 * (lane >> 4)) = pack4(accC[t]);
        if ((lane & 15) == 0) {
#pragma unroll
            for (int r = 0; r < 4; ++r) nvec[16 * wid + 4 * (lane >> 4) + r] = accN[r]; }
    }
    if (!si.samp) {
        state_store(accC, f.out + OUT_C + sidx * 16384, eh, f);
        if (eh == 0) {
            if ((lane & 15) == 0) {
#pragma unroll
                for (int r = 0; r < 4; ++r) f.out[OUT_N + sidx * 128 + 16 * wid + 4 * (lane >> 4) + r] = accN[r]; }
            if (tid == 0) f.out[OUT_M + sidx] = m_prev;
        }
    }
    if (f.tid == 0) *(volatile LAS int*)(f.lds + LDS_BYTES - 128) = nxt;
}

__device__ __forceinline__ void delta_item(const Params& p, int l, int seq, int h, int dir, int eh, unsigned* qnext, const Frame& f) {
    LAS bf16_t* q = (LAS bf16_t*)(f.lds + SC_Q); LAS bf16_t* Wk = (LAS bf16_t*)(f.lds + SC_K);
    LAS bf16_t* UT = (LAS bf16_t*)(f.lds + SC_V); LAS bf16_t* ST = (LAS bf16_t*)(f.lds + SC_ST);
    constexpr int SC_KE2 = 96768, SC_QK2 = 115200;
    LAS float* veg = (LAS float*)(f.lds + SC_VEC);
    const bf16_t* QN = (const bf16_t*)(f.ws + WS_QN); const bf16_t* KNg = (const bf16_t*)(f.ws + WS_KT); const bf16_t* U0T = (const bf16_t*)(f.ws + WS_U0T);
    const bf16_t* WKg = (const bf16_t*)(f.ws + WS_WK); const bf16_t* QKD = (const bf16_t*)(f.ws + WS_QKD); const float* GCH = (const float*)(f.ws + WS_GCH);
    bf16_t* HS = (bf16_t*)(f.ws + WS_HS) + (size_t)(1 * 2 + dir) * MROWS * 1024;
    const SeqInfo si = seq_info(seq);
    const int tid = f.tid, lane = f.lane, wid = f.wid;
    const size_t sidx = state_index(si.b, l, dir, h);
    f32x4 accS[4];
    __syncthreads();
    state_load(accS, si.samp ? p.in[I_SD] + sidx * 16384 : nullptr, eh, ST, f);
    const int si_i = tid >> 3, si_s = tid & 7;
    const int ti_u = wid >> 1, te_u0 = 2 * (wid & 1);
    u32x4 rq1, rq2, rw1, rw2, rk1, rk2, rqk; u32x2 ru0, ru1; float rG = 0.f, rGl = 0.f;
    {
        const int cn = dir ? si.NC - 1 : 0, row0 = si.rowbase + 64 * cn, chd = ((row0 >> 6) * 8 + h) * 2 + dir;
        const bf16_t* sq = QN + (size_t)(row0 + si_i) * 1024 + h * 128 + 16 * si_s; rq1 = *(const u32x4*)sq; rq2 = *(const u32x4*)(sq + 8);
        const bf16_t* sk = KNg + (size_t)(row0 + si_i) * 1024 + h * 128 + 16 * si_s; rk1 = *(const u32x4*)sk; rk2 = *(const u32x4*)(sk + 8);
        const bf16_t* sw = WKg + (size_t)chd * 8192 + si_i * 128 + 16 * si_s; rw1 = *(const u32x4*)sw; rw2 = *(const u32x4*)(sw + 8);
        rqk = *(const u32x4*)(QKD + (size_t)chd * 4096 + si_i * 64 + 8 * si_s);
        const bf16_t* su = U0T + (size_t)chd * 8192 + (size_t)(64 * eh + 16 * te_u0 + (lane & 15)) * 64 + 16 * ti_u + 4 * (lane >> 4);
        ru0 = *(const u32x2*)su; ru1 = *(const u32x2*)(su + 16 * 64);
        rG = GCH[(size_t)chd * 64 + si_i]; rGl = GCH[(size_t)chd * 64 + (dir ? 0 : 63)];
    }
    int nxt;
#pragma unroll 1
    for (int n = 0; n < si.NC; ++n) {
        const int cn = dir ? si.NC - 1 - n : n, row0 = si.rowbase + 64 * cn;
        const float Glast = rGl;
        const u32x2 cu0 = ru0, cu1 = ru1;
        LAS bf16_t* ke = (LAS bf16_t*)(f.lds + SC_K2); LAS bf16_t* QKd = (LAS bf16_t*)(f.lds + SC_P);
#pragma unroll 1
        for (int rep = 0; rep < ((PROBE_SEG == 6) ? 2 : 1); ++rep)
        {
            const int i = si_i, s = si_s;
            *(LAS u32x4*)(q + i * PA + 16 * s) = rq1; *(LAS u32x4*)(q + i * PA + 16 * s + 8) = rq2;
            *(LAS u32x4*)(Wk + i * PA + 16 * s) = rw1; *(LAS u32x4*)(Wk + i * PA + 16 * s + 8) = rw2;
            *(LAS u32x4*)(QKd + i * PB + 8 * s) = rqk;
            float x0[8], x1[8];
            unpack8(rk1, x0); unpack8(rk2, x1);
            const float ksc = __expf(Glast - rG);
#pragma unroll
            for (int j = 0; j < 8; ++j) { x0[j] *= ksc; x1[j] *= ksc; }
            *(LAS u32x4*)(ke + i * PA + 16 * s) = pack8(x0); *(LAS u32x4*)(ke + i * PA + 16 * s + 8) = pack8(x1);
            if (s == 0) veg[i] = __expf(rG);
        }
        if (n + 1 < si.NC) {
            const int cn2 = dir ? si.NC - 2 - n : n + 1, row2 = si.rowbase + 64 * cn2, chd = ((row2 >> 6) * 8 + h) * 2 + dir;
            const bf16_t* sq = QN + (size_t)(row2 + si_i) * 1024 + h * 128 + 16 * si_s; rq1 = *(const u32x4*)sq; rq2 = *(const u32x4*)(sq + 8);
            const bf16_t* sk = KNg + (size_t)(row2 + si_i) * 1024 + h * 128 + 16 * si_s; rk1 = *(const u32x4*)sk; rk2 = *(const u32x4*)(sk + 8);
            const bf16_t* sw = WKg + (size_t)chd * 8192 + si_i * 128 + 16 * si_s; rw1 = *(const u32x4*)sw; rw2 = *(const u32x4*)(sw + 8);
            rqk = *(const u32x4*)(QKD + (size_t)chd * 4096 + si_i * 64 + 8 * si_s);
            const bf16_t* su = U0T + (size_t)chd * 8192 + (size_t)(64 * eh + 16 * te_u0 + (lane & 15)) * 64 + 16 * ti_u + 4 * (lane >> 4);
            ru0 = *(const u32x2*)su; ru1 = *(const u32x2*)(su + 16 * 64);
            rG = GCH[(size_t)chd * 64 + si_i]; rGl = GCH[(size_t)chd * 64 + (dir ? 0 : 63)];
        }
        if (n == si.NC - 1 && f.tid == 0) { unsigned zo = 0; asm volatile("" : "+v"(zo)); nxt = (int)__hip_atomic_fetch_add(qnext + zo, 1u, __ATOMIC_RELAXED, __HIP_MEMORY_SCOPE_AGENT); }
        __syncthreads();
#pragma unroll 1
        for (int rep = 0; rep < ((PROBE_SEG == 5) ? 2 : 1); ++rep)
        {
            f32x4 a0 = {0.f, 0.f, 0.f, 0.f}, a1 = a0;
#pragma unroll
            for (int ks = 0; ks < 4; ++ks) {
                const bf16x8 a = rd_frag(Wk, PA, 16 * ti_u, 32 * ks, lane);
                a0 = mfma16(a, rd_frag(ST, PA, 16 * te_u0, 32 * ks, lane), a0);
                a1 = mfma16(a, rd_frag(ST, PA, 16 * te_u0 + 16, 32 * ks, lane), a1);
            }
            const int i0 = 16 * ti_u + 4 * (lane >> 4);
            f32x4 u; u[0] = bflo(cu0.x) - a0[0]; u[1] = bfhi(cu0.x) - a0[1]; u[2] = bflo(cu0.y) - a0[2]; u[3] = bfhi(cu0.y) - a0[3];
            *(LAS u32x2*)(UT + (16 * te_u0 + (lane & 15)) * PB + i0) = pack4(u);
            u[0] = bflo(cu1.x) - a1[0]; u[1] = bfhi(cu1.x) - a1[1]; u[2] = bflo(cu1.y) - a1[2]; u[3] = bfhi(cu1.y) - a1[3];
            *(LAS u32x2*)(UT + (16 * te_u0 + 16 + (lane & 15)) * PB + i0) = pack4(u);
        }
        const int te = wid >> 1, ti0 = 2 * (wid & 1);
        f32x4 accO[2] = {{0.f, 0.f, 0.f, 0.f}, {0.f, 0.f, 0.f, 0.f}};
#pragma unroll
        for (int ks = 0; ks < 4; ++ks) {
            const bf16x8 a = rd_frag(ST, PA, 16 * te, 32 * ks, lane);
            accO[0] = mfma16(a, rd_frag(q, PA, 16 * ti0, 32 * ks, lane), accO[0]);
            accO[1] = mfma16(a, rd_frag(q, PA, 16 * ti0 + 16, 32 * ks, lane), accO[1]);
        }
        accO[0] *= veg[16 * ti0 + (lane & 15)];
        accO[1] *= veg[16 * ti0 + 16 + (lane & 15)];
        __syncthreads();
#pragma unroll
        for (int ks = 0; ks < 2; ++ks) {
            const bf16x8 a = rd_frag(UT, PB, 16 * te, 32 * ks, lane);
            accO[0] = mfma16(a, rd_frag(QKd, PB, 16 * ti0, 32 * ks, lane), accO[0]);
            accO[1] = mfma16(a, rd_frag(QKd, PB, 16 * ti0 + 16, 32 * ks, lane), accO[1]);
        }
#pragma unroll
        for (int t = 0; t < 2; ++t)
            *(u32x2*)(HS + (size_t)(row0 + 16 * (ti0 + t) + (lane & 15)) * 1024 + h * 128 + 64 * eh + 16 * te + 4 * (lane >> 4)) = pack4(accO[t]);
        {
            const float cd = __expf(Glast);
            const bf16x8 a0 = tr_frag(ke, PA, 0, 16 * wid, lane), a1 = tr_frag(ke, PA, 32, 16 * wid, lane);
#pragma unroll
            for (int t = 0; t < 4; ++t) {
                accS[t] = mfma16(a0, rd_frag(UT, PB, 16 * t, 0, lane), accS[t] * cd);
                accS[t] = mfma16(a1, rd_frag(UT, PB, 16 * t, 32, lane), accS[t]);
                *(LAS u32x2*)(ST + (16 * t + (lane & 15)) * PA + 16 * wid + 4 * (lane >> 4)) = pack4(accS[t]);
            }
        }
        __syncthreads();
    }
    if (!si.samp) state_store(accS, f.out + OUT_DS + sidx * 16384, eh, f);
    if (f.tid == 0) *(volatile LAS int*)(f.lds + LDS_BYTES - 128) = nxt;
}

__device__ __forceinline__ int scan_dequeue(unsigned* q, const Frame& f) {
    volatile LAS int* slot = (volatile LAS int*)(f.lds + LDS_BYTES - 128);
    __syncthreads();
    if (f.tid == 0) *slot = (int)__hip_atomic_fetch_add(q, 1u, __ATOMIC_RELAXED, __HIP_MEMORY_SCOPE_AGENT);
    __syncthreads();
    return *slot;
}
__device__ __forceinline__ bool scan_decode(int g, int& seq, int& h, int& dir, int& eh) {
    if (g >= 576) return false;
    if (g < 64) { seq = 16 + (g >> 5); h = (g >> 2) & 7; dir = (g >> 1) & 1; eh = g & 1; return true; }
    const int idx = g - 64; seq = idx >> 5; h = (idx >> 2) & 7; dir = (idx >> 1) & 1; eh = idx & 1; return true;
}
__device__ __forceinline__ void phase_scan(const Params& p, int l, const Frame& f, int mask = 7) {
    unsigned* q = (unsigned*)(f.ws + WS_QUEUE) + (size_t)l * 3 * 64;
    const int start = (f.bid < 64 || f.bid >= 192) ? 0 : (f.bid < 128 ? 1 : 2);
    const bool stat = (f.G == 256) && (mask == 7);
    volatile LAS int* slot = (volatile LAS int*)(f.lds + LDS_BYTES - 128);
    int seq, h, dir, eh;
#pragma unroll 1
    for (int r = 0; r < 3; ++r) {
        const int X = (start + r) % 3;
        if (!((mask >> X) & 1)) continue;
        const int base = stat ? (X == 0 ? 128 : 64) : 0;
        int g = (stat && r == 0) ? (f.bid < 64 ? f.bid : (f.bid >= 192 ? f.bid - 128 : (f.bid & 63))) : scan_dequeue(q + 64 * X, f) + base;
#pragma unroll 1
        for (;;) {
            if (!scan_decode(g, seq, h, dir, eh)) break;
            Frame fi = f; { int t = f.tid; asm volatile("" : "+v"(t)); fi.tid = t; fi.lane = t & 63; }
            if (X == 0) mlstm_item(p, l, seq, h, dir, eh, q + 64 * X, fi);
            else if (X == 1) delta_item(p, l, seq, h, dir, eh, q + 64 * X, fi);
            else ret_item(p, l, seq, h, dir, eh, q + 64 * X, fi);
            __syncthreads();
            g = *slot + base;
        }
    }
}

template <class Epi> __device__ __forceinline__ void run_gemm(const bf16_t* A, const bf16_t* Bt, int N, int K, const Epi& E, const Frame& f) {
    pg8::Gemm g{A, Bt, MROWS, N, K};
    pg8::StaticOrder S; S.init(MROWS, N, f.G, f.bid, N > 8192 ? WGM_WIN : (N == 8192 ? WGM_UP : WGM_N2K));
    pg8::gemm_phase<Epi, pg8::StaticOrder, true, true>(f.lds, g, S, E);
}
__device__ __forceinline__ void phase_ffn_up(const Params& p, int l, int j, const Frame& f) {
    pg8::EpiSwiglu E{(bf16_t*)(f.ws + WS_HID), 4096, (const float*)(f.ws + WS_SS) + (size_t)(l * 3 + (j == 0 ? 0 : 2)) * MROWS,
                     (const float*)(f.ws + WS_SHW) + (size_t)l * SHW_LAYER + (j == 0 ? 0 : SHW_UP1)};
    run_gemm((const bf16_t*)(f.ws + (j == 0 ? WS_H : WS_XB3)), (const bf16_t*)(f.ws + wofs(l) + WS_W13T) + (size_t)j * 8192 * 2048, 8192, 2048, E, f);
}
template <int j> __device__ __forceinline__ void phase_ffn_down(const Params& p, int l, const Frame& f) {
    const float* ada_l = (const float*)(f.ws + WS_ADA) + (size_t)l * 3 * 18432;
    const bool lastl = (j == 1 && l == 1);
    const int nl = lastl ? 1 : ((j == 0) ? l : l + 1), nw = (j == 0) ? 1 : 0;
    const bool firstres = (j == 0 && l == 0);
    pg8::EpiResid<(j == 0 ? 2 : 8), true> E{f.out + OUT_Y, ada_l, firstres ? p.in[I_XP] : f.out + OUT_Y, firstres ? p.in[I_XS] - (size_t)4096 * 2048 : f.out + OUT_Y,
                    (bf16_t*)(f.ws + WS_H), p.in[I_NORMG] + (size_t)(nl * 3 + nw) * 2048,
                    (const float*)(f.ws + WS_ADA) + (size_t)nl * 3 * 18432 + (size_t)(3 * nw + 1) * 2048,
                    (float*)(f.ws + WS_SS) + (size_t)(lastl ? 6 : nl * 3 + nw) * MROWS, lastl ? 0 : 1};
    run_gemm((const bf16_t*)(f.ws + WS_HID), (const bf16_t*)(f.ws + wofs(l) + WS_W2T) + (size_t)j * 2048 * 4096, 2048, 4096, E, f);
    convert_fill(p, l, j == 0 ? 0 : 5, f);
}
__device__ __forceinline__ void phase_win(const Params& p, int l, const Frame& f) {
    pg8::EpiWin E{(bf16_t*)(f.ws + WS_PQ), (bf16_t*)(f.ws + WS_PG), (float*)(f.ws + WS_GT), (const float*)(f.ws + (l ? WS_BIASP1 : WS_BIASP)),
                  (const float*)(f.ws + WS_SS) + (size_t)(l * 3 + 1) * MROWS, (const float*)(f.ws + WS_SHW) + (size_t)l * SHW_LAYER + SHW_WIN};
    run_gemm((const bf16_t*)(f.ws + WS_H), (const bf16_t*)(f.ws + wofs(l) + WS_WINT), NINP, 2048, E, f);
    convert_fill(p, l, 6, f);
}
__device__ __forceinline__ void phase_br(const Params& p, int l, const Frame& f) {
#pragma unroll 1
    for (int seg = 0; seg < 3; ++seg) {
        pg8::EpiBr E{(const bf16_t*)(f.ws + WS_PG), (float*)(f.ws + WS_TMP), (bf16_t*)(f.ws + WS_H), seg};
        run_gemm((const bf16_t*)(f.ws + WS_YS) + (size_t)seg * MROWS * 1024, (const bf16_t*)(f.ws + wofs(l) + WS_WBRT) + (size_t)seg * 2048 * 1024, 2048, 1024, E, f);
        convert_fill(p, l, 1 + seg, f);
        asm volatile("s_waitcnt vmcnt(0)" ::: "memory");
        __syncthreads();
    }
}
__device__ __forceinline__ void phase_wout(const Params& p, int l, const Frame& f) {
    const float* ada_l = (const float*)(f.ws + WS_ADA) + (size_t)l * 3 * 18432;
    pg8::EpiResid<5, false> E{f.out + OUT_Y, ada_l, f.out + OUT_Y, f.out + OUT_Y, (bf16_t*)(f.ws + WS_XB3), p.in[I_NORMG] + (size_t)(l * 3 + 2) * 2048, ada_l + (size_t)7 * 2048, (float*)(f.ws + WS_SS) + (size_t)(l * 3 + 2) * MROWS, 1};
    run_gemm((const bf16_t*)(f.ws + WS_H), (const bf16_t*)(f.ws + wofs(l) + WS_WOUTT), 2048, 2048, E, f);
    convert_fill(p, l, 4, f);
}

constexpr int N_PHASES = 14;
template <int PH> __device__ __forceinline__ void do_phase(const Params& p, int l, const Frame& f) {
    if constexpr (PH == 0) { phase_rope(p, f); if (f.G == 256) phase_ada(p, 0, f.bid, f.G, f, 0, 256); else { phase_ada(p, 0, f.bid, f.G, f); phase_ada(p, 1, f.bid, f.G, f); } }
    else if constexpr (PH == 1) { phase_convert(p, l, f); if (l == 0) { phase_copy_norm(p, f); if (f.G == 256) phase_ada(p, 0, f.bid, f.G, f, 256, 9 * 128); } }
    else if constexpr (PH == 2) phase_ffn_up(p, l, 0, f);
    else if constexpr (PH == 3) phase_ffn_down<0>(p, l, f);
    else if constexpr (PH == 5) phase_win(p, l, f);
    else if constexpr (PH == 6) phase_delta_prep(p, l, f);
    else if constexpr (PH == 7) phase_scan(p, l, f);
    else if constexpr (PH == 107) phase_scan(p, l, f, PROBE_SCAN_MASK);
    else if constexpr (PH == 8) phase_merge(p, l, f);
    else if constexpr (PH == 9) phase_br(p, l, f);
    else if constexpr (PH == 10) phase_wout(p, l, f);
    else if constexpr (PH == 12) phase_ffn_up(p, l, 1, f);
    else if constexpr (PH == 13) phase_ffn_down<1>(p, l, f);
    else if constexpr (PH == 14) phase_final_norm(p, f);
}
__device__ __forceinline__ Frame make_frame(unsigned char* lds_generic, const Params& p) {
    int t = threadIdx.x; asm volatile("" : "+v"(t));
    int b = blockIdx.x; asm volatile("" : "+s"(b));
    Frame f; f.tid = t; f.wid = __builtin_amdgcn_readfirstlane(t >> 6); f.lane = t & 63; f.bid = b; f.G = gridDim.x;
    size_t z = 0; asm volatile("" : "+s"(z));
    f.ws = p.ws + z; f.out = p.out + z;
    f.lds = (LAS unsigned char*)lds_generic; return f;
}

#if ONE_LAUNCH
__global__ void __launch_bounds__(512, 2) mega_fwd(Params p, int step_first, int step_last) {
    extern __shared__ __attribute__((aligned(16))) unsigned char lds_raw[];
    volatile LAS unsigned* xbw = (volatile LAS unsigned*)((LAS unsigned char*)lds_raw + LDS_WORK);
    if (threadIdx.x < 4) xbw[threadIdx.x] = 0u;
    __syncthreads();
    XcdBarrier bar = xcd_barrier_post((unsigned*)(p.ws + WS_CTL), xbw);
#ifndef PROBE_DUP
#define PROBE_DUP 0
#endif
#define MK_PHASE(k) if (step >= step_first && step < step_last) { { const Frame f = make_frame(lds_raw, p); do_phase<k>(p, l, f); } xcd_barrier(bar); if (PROBE_BAR) xcd_barrier(bar); } ++step; \
    if constexpr ((PROBE_DUP >> k) & 1) { { const Frame f = make_frame(lds_raw, p); do_phase<(k == 7 ? 107 : k)>(p, l, f); } xcd_barrier(bar); }
    int step = 0;
#pragma unroll 1
    for (int l = 0; l < 2; ++l) {
        if (l == 0) { MK_PHASE(0) }
        if (l == 0 || gridDim.x != 256) { MK_PHASE(1) }
        MK_PHASE(2) MK_PHASE(3) MK_PHASE(5) MK_PHASE(6) MK_PHASE(7) MK_PHASE(8) MK_PHASE(9) MK_PHASE(10) MK_PHASE(12) MK_PHASE(13)
    }
    if (step_last < 1000) return;
    const Frame f = make_frame(lds_raw, p);
    do_phase<14>(p, 0, f);
}
#else
template <int PH> __global__ void __launch_bounds__(512, 2) phase_kernel(Params p, int l) {
    extern __shared__ __attribute__((aligned(16))) unsigned char lds_raw[];
    const Frame f = make_frame(lds_raw, p);
    do_phase<PH>(p, l, f);
}
template <int PH> static void launch_phase(const Params& p, int l, int grid, hipStream_t stream) {
    static bool attr_done = false;
    if (!attr_done) { (void)hipFuncSetAttribute((const void*)phase_kernel<PH>, hipFuncAttributeMaxDynamicSharedMemorySize, LDS_BYTES); attr_done = true; }
    hipLaunchKernelGGL(phase_kernel<PH>, dim3(grid), dim3(NTHREADS), LDS_BYTES, stream, p, l);
}
#endif

#if !ONE_LAUNCH
__global__ void dump_kernel(Params p, size_t off_bytes, int nslices) {
    const bf16_t* b = (const bf16_t*)(p.ws + off_bytes);
    const size_t n = 12582912;
    for (size_t i = (size_t)blockIdx.x * blockDim.x + threadIdx.x; i < 2 * n; i += (size_t)gridDim.x * blockDim.x) {
        float v = 1.0f;
        if (i < n) { v = 0.f; for (int k = 0; k < nslices; ++k) v += (float)(k + 1) * bflo((unsigned)b[(size_t)k * n + i]); }
        p.out[i] = v;
    }
}
#endif
extern "C" void kernel_launch(void* const* d_in, const int* in_sizes, int n_in, void* d_out, int out_size, void* d_ws, size_t ws_size, hipStream_t stream) {
    if (n_in != N_INPUTS || (size_t)out_size != OUT_TOTAL || ws_size < WS_END) {
        fprintf(stderr, "kernel_launch: unexpected sizes: n_in %d out %d ws %zu (need %zu); nothing launched\n", n_in, out_size, ws_size, (size_t)WS_END); return; }
    Params p{};
    for (int i = 0; i < N_INPUTS; ++i) p.in[i] = (const float*)d_in[i];
    p.out = (float*)d_out; p.ws = (unsigned char*)d_ws;
    if (hipMemsetAsync((char*)d_ws + WS_CTL, 0, CTL_BYTES, stream) != hipSuccess) { fprintf(stderr, "kernel_launch: memset failed\n"); return; }
    static int grid = 0;
    if (!grid) {
        int dev = 0, cus = 0;
        if (hipGetDevice(&dev) != hipSuccess || hipDeviceGetAttribute(&cus, hipDeviceAttributeMultiprocessorCount, dev) != hipSuccess || cus <= 0) cus = 256;
        grid = cus;
#if ONE_LAUNCH
        if (hipFuncSetAttribute((const void*)mega_fwd, hipFuncAttributeMaxDynamicSharedMemorySize, LDS_BYTES) != hipSuccess) fprintf(stderr, "kernel_launch: hipFuncSetAttribute failed\n");
        int per_cu = 0;
        if (hipOccupancyMaxActiveBlocksPerMultiprocessor(&per_cu, (const void*)mega_fwd, NTHREADS, LDS_BYTES) != hipSuccess || per_cu < 1)
            fprintf(stderr, "kernel_launch: occupancy query reports %d workgroups per CU\n", per_cu);
#endif
    }
#if ONE_LAUNCH
#ifndef SPLIT_AT
    hipLaunchKernelGGL(mega_fwd, dim3(grid), dim3(NTHREADS), LDS_BYTES, stream, p, 0, 1000);
#else
    hipLaunchKernelGGL(mega_fwd, dim3(grid), dim3(NTHREADS), LDS_BYTES, stream, p, 0, (int)(SPLIT_AT));
    if (hipMemsetAsync((char*)d_ws + WS_CTL, 0, 16384, stream) != hipSuccess) return;
    hipLaunchKernelGGL(mega_fwd, dim3(grid), dim3(NTHREADS), LDS_BYTES, stream, p, (int)(SPLIT_AT), 1000);
#endif
#else
#ifndef STOP_AT
#define STOP_AT 1000
#endif
    int step = 0;
#define LP(k) if (step++ < STOP_AT) launch_phase<k>(p, l, grid, stream);
    for (int l = 0; l < 2; ++l) { if (l == 0) { LP(0) } LP(1) LP(2) LP(3) LP(5) LP(6) LP(7) LP(8) LP(9) LP(10) LP(12) LP(13) }
#ifdef DUMP_OFF
    hipLaunchKernelGGL(dump_kernel, dim3(2048), dim3(256), 0, stream, p, (size_t)(DUMP_OFF), (int)(DUMP_N));
#endif
    if (STOP_AT >= 1000)
    launch_phase<14>(p, 0, grid, stream);
#endif
}
```

```cpp
#include <hip/hip_runtime.h>
#include <cstdio>
#include <cstdint>

#define XB_TMO      128
#define XB_XCNT(j)  (256  + 64 * (j))
#define XB_XSUB(j)  (1280 + 64 * (j))
#define XB_XGEN(j)  (2304 + 64 * (j))
#define XB_TOP      3328
#define XB_TOPGEN   3392
#define XCD_BAR_WORDS 3456
#define XB_SPIN_CAP (1u << 18)
#define LAS __attribute__((address_space(3)))

__device__ __forceinline__ unsigned xb_ld(unsigned* p)              { return __hip_atomic_load(p, __ATOMIC_RELAXED, __HIP_MEMORY_SCOPE_AGENT); }
__device__ __forceinline__ unsigned xb_add(unsigned* p, unsigned v) { return __hip_atomic_fetch_add(p, v, __ATOMIC_RELAXED, __HIP_MEMORY_SCOPE_AGENT); }
__device__ __forceinline__ unsigned xb_xcc_id() { return (unsigned)__builtin_amdgcn_s_getreg((3 << 11) | 20) & 0xFu; }
#define XB_SPIN(cond, bar) do { unsigned _sp = 0; while (cond) { __builtin_amdgcn_s_sleep(1); \
    if ((++_sp & 255u) == 0u) { if (xb_ld(&(bar)[XB_TMO])) break; if (_sp > XB_SPIN_CAP) { atomicAdd(&(bar)[XB_TMO], 1u); break; } } } } while (0)

struct XcdBarrier {
    unsigned* bar; unsigned x;
    volatile LAS unsigned* st;
};

__device__ __forceinline__ XcdBarrier xcd_barrier_post(unsigned* bar, volatile LAS unsigned* st) {
    XcdBarrier b; b.bar = bar; b.x = xb_xcc_id(); b.st = st;
    if (threadIdx.x == 0) (void)xb_add(&bar[XB_XCNT(b.x)], 1u);
    return b;
}
__device__ __forceinline__ void xcd_barrier_complete(unsigned* bar, unsigned x, unsigned& nloc, unsigned& nx) {
    const unsigned G = gridDim.x * gridDim.y * gridDim.z;
    unsigned sum, cnt, mine, sp = 0u;
    for (;;) {
        sum = 0u; cnt = 0u; mine = 0u;
#pragma unroll
        for (unsigned j = 0; j < 16; ++j) { const unsigned c = xb_ld(&bar[XB_XCNT(j)]); sum += c; cnt += (c > 0u) ? 1u : 0u; mine = (j == x) ? c : mine; }
        if (sum == G) break;
        __builtin_amdgcn_s_sleep(1);
        if ((++sp & 255u) == 0u) { if (xb_ld(&bar[XB_TMO])) break; if (sp > XB_SPIN_CAP) { atomicAdd(&bar[XB_TMO], 1u); break; } }
    }
    nloc = mine > 0u ? mine : 1u; nx = cnt > 0u ? cnt : 1u;
}

__device__ __forceinline__ void xcd_barrier(const XcdBarrier& b) {
    asm volatile("s_waitcnt vmcnt(0)" ::: "memory");
    __syncthreads();
    if (threadIdx.x == 0) {
        unsigned* bar = b.bar;
        __builtin_amdgcn_s_waitcnt(0);
        unsigned nloc = b.st[0], nx = b.st[1];
        if (nloc == 0u) { xcd_barrier_complete(bar, b.x, nloc, nx); b.st[0] = nloc; b.st[1] = nx; }
        const unsigned old = xb_add(&bar[XB_XSUB(b.x)], 1u);
        const unsigned gen = old / nloc;
        if (old + 1u == (gen + 1u) * nloc) {
            __builtin_amdgcn_fence(__ATOMIC_RELEASE, "agent");
            asm volatile("s_waitcnt vmcnt(0)" ::: "memory");
            const unsigned og = xb_add(&bar[XB_TOP], 1u);
            const unsigned tg = og / nx;
            if (og + 1u == (tg + 1u) * nx) xb_add(&bar[XB_TOPGEN], 1u);
            else XB_SPIN(xb_ld(&bar[XB_TOPGEN]) == tg, bar);
            __builtin_amdgcn_fence(__ATOMIC_ACQUIRE, "agent");
            xb_add(&bar[XB_XGEN(b.x)], 1u);
            asm volatile("s_waitcnt vmcnt(0)" ::: "memory");
        } else {
            XB_SPIN(xb_ld(&bar[XB_XGEN(b.x)]) == gen, bar);
            __builtin_amdgcn_fence(__ATOMIC_ACQUIRE, "agent");
            asm volatile("s_waitcnt vmcnt(0)" ::: "memory");
        }
    }
    __syncthreads();
}


namespace pg8 {
#define PG8_LAS __attribute__((address_space(3)))
typedef unsigned short bf16_t;
typedef short bf16x8 __attribute__((ext_vector_type(8)));
typedef float f32x4 __attribute__((ext_vector_type(4)));
typedef unsigned u32x4 __attribute__((ext_vector_type(4)));
typedef unsigned u32x2 __attribute__((ext_vector_type(2)));
constexpr int BM = 256, BK = 64, HALF = 128, HTB = HALF * BK * 2  , STAGE_BYTES = 8 * HTB, NXCD = 8, WGM = 4;

__host__ __device__ __forceinline__ int lds_byte(int r, int c) { const int st = (r >> 4) * 2 + (c >> 5), rr = r & 15, cc = c & 31, ob = rr * 64 + cc * 2; return st * 1024 + (ob ^ (((ob >> 9) & 1) << 5)); }
__host__ __device__ __forceinline__ void stage_rc(int b, int& R, int& C) { const int st = b / 1024, sb = b % 1024, swz = sb ^ (((sb >> 9) & 1) << 5); R = (st >> 1) * 16 + swz / 64; C = (st & 1) * 32 + (swz % 64) / 2; }
__host__ __device__ __forceinline__ int perm32(int rho) { const int n = rho >> 4, i = rho & 15; return 8 * (i >> 2) + 4 * n + (i & 3); }

struct Unit { int pm, pn; };
struct Gemm { const bf16_t* A; const bf16_t* Bt; int M, N, K; };

struct StaticOrder {
    int nM, nN, nwg, G, c, wgm;
    __host__ __device__ void init(int M, int N, int G_, int c_, int wgm_ = WGM) { nM = M / BM; nN = N / BM; nwg = nM * nN; G = G_; c = c_; wgm = wgm_; }
    __host__ __device__ bool next(int i, Unit& u) const {
        const long L = (long)i * G + c; if (L >= nwg) return false;
        int wgid = (int)L; { const int q = nwg / NXCD, r = nwg % NXCD, xcd = wgid % NXCD, off = wgid / NXCD; wgid = (xcd < r ? xcd * (q + 1) : r * (q + 1) + (xcd - r) * q) + off; }
        const int nig = wgm * nN, gid = wgid / nig, fm = gid * wgm, gsz = (nM - fm) < wgm ? (nM - fm) : wgm;
        u.pm = fm + ((wgid % nig) % gsz); u.pn = (wgid % nig) / gsz; return true;
    }
    __device__ __forceinline__ void a_ready(const Unit&) const {}
    __device__ __forceinline__ void done(const Unit&) const {}
};

typedef __bf16 bf16x2_t __attribute__((ext_vector_type(2)));
typedef float f32x2_t __attribute__((ext_vector_type(2)));
__device__ __forceinline__ unsigned cvt_pk_bf16(float lo, float hi) { const f32x2_t v = {lo, hi}; const bf16x2_t b = __builtin_convertvector(v, bf16x2_t); return __builtin_bit_cast(unsigned, b); }
__device__ __forceinline__ float fsigmoid(float x) { return __builtin_amdgcn_rcpf(1.0f + __expf(-x)); }
__device__ __forceinline__ float fsilu(float x) { return x * __builtin_amdgcn_rcpf(1.0f + __expf(-x)); }
__device__ __forceinline__ float bflo(unsigned w) { return __uint_as_float(w << 16); }
__device__ __forceinline__ float bfhi(unsigned w) { return __uint_as_float(w & 0xffff0000u); }

struct EpiSwiglu {
    static constexpr bool PERM = true, AFTER_DRAIN = false;
    bf16_t* O; int ldo; const float* SS; const float* shW;
    __device__ __forceinline__ void operator()(const f32x4 (&acc)[2][2][4][2], const Unit& u, int wr, int wc, int fr, int fq) const {
        const int row0 = u.pm * BM + wr * 64 + fr, col0 = u.pn * HALF + wc * 32 + 8 * fq;
        const int rb = u.pm < 16 ? 0 : (u.pm < 32 ? 1 : 2);
        const float* sw = shW + (size_t)rb * 8192 + u.pn * BM + wc * 32 + 8 * fq;
        const f32x4 sa0 = *(const f32x4*)sw, sa1 = *(const f32x4*)(sw + 4), sb0 = *(const f32x4*)(sw + HALF), sb1 = *(const f32x4*)(sw + HALF + 4);
        float rstdv[2][4];
#pragma unroll
        for (int ai = 0; ai < 2; ++ai)
#pragma unroll
            for (int m = 0; m < 4; ++m) rstdv[ai][m] = rsqrtf(SS[row0 + ai * HALF + m * 16] * (1.0f / 2048.0f) + 1e-6f);
#pragma unroll
        for (int ai = 0; ai < 2; ++ai)
#pragma unroll
            for (int m = 0; m < 4; ++m) {
                const int row = row0 + ai * HALF + m * 16;
                const float rstd = rstdv[ai][m];
                bf16_t* rowp = O + (size_t)row * ldo + col0;
                const f32x4 a0 = acc[ai][0][m][0] * rstd + sa0, a1 = acc[ai][0][m][1] * rstd + sa1, b0 = acc[ai][1][m][0] * rstd + sb0, b1 = acc[ai][1][m][1] * rstd + sb1;
                u32x4 w;
                w.x = cvt_pk_bf16(fsilu(a0[0]) * b0[0], fsilu(a0[1]) * b0[1]); w.y = cvt_pk_bf16(fsilu(a0[2]) * b0[2], fsilu(a0[3]) * b0[3]);
                w.z = cvt_pk_bf16(fsilu(a1[0]) * b1[0], fsilu(a1[1]) * b1[1]); w.w = cvt_pk_bf16(fsilu(a1[2]) * b1[2], fsilu(a1[3]) * b1[3]);
                *(u32x4*)rowp = w;
            }
    }
};
template <int MODIDX, bool HALFSCALE> struct EpiResid {
    static constexpr bool PERM = true, AFTER_DRAIN = false;
    static constexpr int modidx = MODIDX; static constexpr float scale = HALFSCALE ? 0.5f : 1.0f;
    float* X; const float* ada;
    const float* Xrp; const float* Xrs;
    bf16_t* XB; const float* gnext; const float* scnext; float* SS; int has_xb;
    __device__ __forceinline__ void operator()(const f32x4 (&acc)[2][2][4][2], const Unit& u, int wr, int wc, int fr, int fq) const {
        const int rb = u.pm < 16 ? 0 : (u.pm < 32 ? 1 : 2);
        const float* mv = ada + (size_t)(rb * 9 + modidx) * 2048;
        const int row0 = u.pm * BM + wr * 64 + fr, col0 = u.pn * BM + wc * 32 + 8 * fq;
        f32x4 mvv[2][2], gsv[2][2];
#pragma unroll
        for (int bj = 0; bj < 2; ++bj)
#pragma unroll
            for (int n = 0; n < 2; ++n) { const int c = col0 + bj * HALF + n * 4; mvv[bj][n] = *(const f32x4*)(mv + c) * scale;
                gsv[bj][n] = has_xb ? *(const f32x4*)(gnext + c) * (*(const f32x4*)(scnext + (size_t)rb * 9 * 2048 + c) + 1.0f) : (f32x4){0.f, 0.f, 0.f, 0.f}; }
#pragma unroll
        for (int ai = 0; ai < 2; ++ai)
#pragma unroll
            for (int mp = 0; mp < 2; ++mp) {
                f32x4 xr[2][2][2];
#pragma unroll
                for (int mm = 0; mm < 2; ++mm)
#pragma unroll
                    for (int bj = 0; bj < 2; ++bj) { const size_t row = (size_t)(row0 + ai * HALF + (2 * mp + mm) * 16);
                        const f32x4* r0 = (const f32x4*)((u.pm < 16 ? Xrp : Xrs) + row * 2048 + col0 + bj * HALF); xr[mm][bj][0] = __builtin_nontemporal_load(r0); xr[mm][bj][1] = __builtin_nontemporal_load(r0 + 1); }
#pragma unroll
                for (int mm = 0; mm < 2; ++mm) { const int m = 2 * mp + mm; const size_t row = (size_t)(row0 + ai * HALF + m * 16); float* rowp = X + row * 2048 + col0; float ssq = 0.f;
#pragma unroll
                    for (int bj = 0; bj < 2; ++bj) {
                        f32x4* p0 = (f32x4*)(rowp + bj * HALF); f32x4* p1 = p0 + 1;
                        const f32x4 x0 = xr[mm][bj][0] + mvv[bj][0] * acc[ai][bj][m][0], x1 = xr[mm][bj][1] + mvv[bj][1] * acc[ai][bj][m][1];
                        __builtin_nontemporal_store(x0, p0); __builtin_nontemporal_store(x1, p1);
                        ssq += ((x0[0] * x0[0] + x0[1] * x0[1]) + (x0[2] * x0[2] + x0[3] * x0[3])) + ((x1[0] * x1[0] + x1[1] * x1[1]) + (x1[2] * x1[2] + x1[3] * x1[3]));
                        if (has_xb) { const f32x4 y0 = x0 * gsv[bj][0], y1 = x1 * gsv[bj][1];
                            u32x4 w; w.x = cvt_pk_bf16(y0[0], y0[1]); w.y = cvt_pk_bf16(y0[2], y0[3]); w.z = cvt_pk_bf16(y1[0], y1[1]); w.w = cvt_pk_bf16(y1[2], y1[3]);
                            *(u32x4*)(XB + row * 2048 + col0 + bj * HALF) = w; } }
                    ssq += __shfl_xor(ssq, 16); ssq += __shfl_xor(ssq, 32);
                    if (fq == 0) atomicAdd(SS + row, ssq); }
            }
    }
};
struct EpiWin {
    static constexpr bool PERM = true, AFTER_DRAIN = false;
    bf16_t* PQ; bf16_t* PG; float* GT; const float* biasp; const float* SS; const float* shW;
    __device__ __forceinline__ void operator()(const f32x4 (&acc)[2][2][4][2], const Unit& u, int wr, int wc, int fr, int fq) const {
        const int pn = u.pn, row0 = u.pm * BM + wr * 64 + fr, tc = wc * 32 + 8 * fq;
        f32x4 bv[2][2];
#pragma unroll
        for (int bj = 0; bj < 2; ++bj)
#pragma unroll
            for (int n = 0; n < 2; ++n) bv[bj][n] = *(const f32x4*)(biasp + pn * BM + bj * HALF + tc + 4 * n) + *(const f32x4*)(shW + (size_t)(u.pm < 16 ? 0 : (u.pm < 32 ? 1 : 2)) * 18688 + pn * BM + bj * HALF + tc + 4 * n);
        float rstd[2][4];
#pragma unroll
        for (int ai = 0; ai < 2; ++ai)
#pragma unroll
            for (int m = 0; m < 4; ++m) rstd[ai][m] = rsqrtf(SS[row0 + ai * HALF + m * 16] * (1.0f / 2048.0f) + 1e-6f);
        if (pn == 72) {
            if (wc < 2) {
#pragma unroll
                for (int ai = 0; ai < 2; ++ai)
#pragma unroll
                    for (int m = 0; m < 4; ++m) { float* rowp = GT + (size_t)(row0 + ai * HALF + m * 16) * 64 + tc;
                        *(f32x4*)rowp = acc[ai][0][m][0] * rstd[ai][m] + bv[0][0]; *(f32x4*)(rowp + 4) = acc[ai][0][m][1] * rstd[ai][m] + bv[0][1]; }
            }
            return;
        }
        bf16_t* base; int colt, act;
        if (pn < 36) { base = PQ; colt = pn * BM; act = 0; } else { const int q = pn - 36; base = PG; colt = q * BM; act = (q < 4) ? 1 : ((q < 12) ? 2 : 1); }
#pragma unroll
        for (int ai = 0; ai < 2; ++ai)
#pragma unroll
            for (int m = 0; m < 4; ++m) { bf16_t* rowp = base + (size_t)(row0 + ai * HALF + m * 16) * 9216 + colt + tc;
#pragma unroll
                for (int bj = 0; bj < 2; ++bj) { f32x4 v0 = acc[ai][bj][m][0] * rstd[ai][m] + bv[bj][0], v1 = acc[ai][bj][m][1] * rstd[ai][m] + bv[bj][1];
                    if (act == 1) {
#pragma unroll
                        for (int j = 0; j < 4; ++j) { v0[j] = fsigmoid(v0[j]); v1[j] = fsigmoid(v1[j]); } }
                    else if (act == 2) {
#pragma unroll
                        for (int j = 0; j < 4; ++j) { v0[j] = fsilu(v0[j]); v1[j] = fsilu(v1[j]); } }
                    u32x4 w; w.x = cvt_pk_bf16(v0[0], v0[1]); w.y = cvt_pk_bf16(v0[2], v0[3]); w.z = cvt_pk_bf16(v1[0], v1[1]); w.w = cvt_pk_bf16(v1[2], v1[3]);
                    *(u32x4*)(rowp + bj * HALF) = w; } }
    }
};
struct EpiBr {
    static constexpr bool PERM = true, AFTER_DRAIN = false;
    const bf16_t* PG; float* TMP; bf16_t* OUT; int seg;
    __device__ __forceinline__ void operator()(const f32x4 (&acc)[2][2][4][2], const Unit& u, int wr, int wc, int fr, int fq) const {
        const int row0 = u.pm * BM + wr * 64 + fr, col0 = u.pn * BM + wc * 32 + 8 * fq;
#pragma unroll
        for (int ai = 0; ai < 2; ++ai)
#pragma unroll
            for (int mp = 0; mp < 2; ++mp) {
                u32x4 gwv[2][2], tv[2][2];
#pragma unroll
                for (int mm = 0; mm < 2; ++mm)
#pragma unroll
                    for (int bj = 0; bj < 2; ++bj) { const size_t row = (size_t)(row0 + ai * HALF + (2 * mp + mm) * 16); const int c = col0 + bj * HALF;
                        gwv[mm][bj] = *(const u32x4*)(PG + row * 9216 + 3072 + seg * 2048 + c);
                        tv[mm][bj] = (seg != 0) ? *(const u32x4*)(OUT + row * 2048 + c) : (u32x4){0u, 0u, 0u, 0u}; }
#pragma unroll
                for (int mm = 0; mm < 2; ++mm)
#pragma unroll
                    for (int bj = 0; bj < 2; ++bj) { const int m = 2 * mp + mm; const size_t row = (size_t)(row0 + ai * HALF + m * 16); const int c = col0 + bj * HALF;
                        const u32x4 gw = gwv[mm][bj], t = tv[mm][bj];
                        f32x4 v0 = acc[ai][bj][m][0], v1 = acc[ai][bj][m][1];
                        v0[0] = v0[0] * bflo(gw.x) + bflo(t.x); v0[1] = v0[1] * bfhi(gw.x) + bfhi(t.x); v0[2] = v0[2] * bflo(gw.y) + bflo(t.y); v0[3] = v0[3] * bfhi(gw.y) + bfhi(t.y);
                        v1[0] = v1[0] * bflo(gw.z) + bflo(t.z); v1[1] = v1[1] * bfhi(gw.z) + bfhi(t.z); v1[2] = v1[2] * bflo(gw.w) + bflo(t.w); v1[3] = v1[3] * bfhi(gw.w) + bfhi(t.w);
                        u32x4 w; w.x = cvt_pk_bf16(v0[0], v0[1]); w.y = cvt_pk_bf16(v0[2], v0[3]); w.z = cvt_pk_bf16(v1[0], v1[1]); w.w = cvt_pk_bf16(v1[2], v1[3]);
                        *(u32x4*)(OUT + row * 2048 + c) = w; }
            }
    }
};

template <class Epi, class Sched, bool ALIGN_EPI = false, bool SP2 = false>
__device__ __forceinline__ void gemm_phase(PG8_LAS unsigned char* lds, const Gemm g, const Sched& S, const Epi& E) {
    int tid_raw = threadIdx.x; asm volatile("" : "+v"(tid_raw));
    const int tid = tid_raw, wid = __builtin_amdgcn_readfirstlane(tid >> 6), lane = tid & 63, wr = wid >> 2, wc = wid & 3, fr = lane & 15, fq = lane >> 4;
    const int K = g.K, nt = K / BK;
    unsigned voffA[2], voffB[2];
#pragma unroll
    for (int i = 0; i < 2; ++i) { int R, C; stage_rc(tid * 16 + i * 8192, R, C); const int Rb = Epi::PERM ? ((R & ~31) + perm32(R & 31)) : R;
        voffA[i] = (unsigned)(R * K + C) * 2u; voffB[i] = (unsigned)(Rb * K + C) * 2u; }
    const size_t kstep = (size_t)(BK * 2);
    const size_t hstep = (size_t)HALF * K * 2;
    const size_t tstep = 2 * hstep;
    const unsigned ldsw = (unsigned)wid * 1024u;
    const int aoff = lds_byte(wr * 64 + fr, fq * 8), boff = lds_byte(wc * 32 + fr, fq * 8);
#define PG8_SA(b, h) (((b) * 2 + (h)) * HTB)
#define PG8_SB(b, h) ((4 + (b) * 2 + (h)) * HTB)
#define PG8_STAGE(bufoff, gbase, voff) do { _Pragma("unroll") for (int _i = 0; _i < 2; ++_i) \
        __builtin_amdgcn_global_load_lds((const unsigned*)((const char*)(gbase) + (voff)[_i]), (PG8_LAS unsigned*)(lds + (bufoff) + ldsw + _i * 8192), 16, 0, 0); } while (0)
#define PG8_LDA(dst, b, h) do { _Pragma("unroll") for (int m = 0; m < 4; ++m) _Pragma("unroll") for (int k = 0; k < 2; ++k) dst[m][k] = *(const PG8_LAS bf16x8*)(lds + PG8_SA(b, h) + aoff + m * 2048 + k * 1024); } while (0)
#define PG8_LDB(dst, b, h) do { _Pragma("unroll") for (int n = 0; n < 2; ++n) _Pragma("unroll") for (int k = 0; k < 2; ++k) dst[n][k] = *(const PG8_LAS bf16x8*)(lds + PG8_SB(b, h) + boff + n * 2048 + k * 1024); } while (0)
#define PG8_MMA(ai, bj, At, Bt) do { __builtin_amdgcn_s_setprio(1); _Pragma("unroll") for (int m = 0; m < 4; ++m) _Pragma("unroll") for (int n = 0; n < 2; ++n) _Pragma("unroll") for (int k = 0; k < 2; ++k) \
        acc[ai][bj][m][n] = __builtin_amdgcn_mfma_f32_16x16x32_bf16(Bt[n][k], At[m][k], acc[ai][bj][m][n], 0, 0, 0); __builtin_amdgcn_s_setprio(0); } while (0)
#define PG8_WAIT_V(n) asm volatile("s_waitcnt vmcnt(" #n ")" ::: "memory")
#define PG8_WAIT_L(n) asm volatile("s_waitcnt lgkmcnt(" #n ")" ::: "memory")
#define PG8_BAR __builtin_amdgcn_s_barrier()
#define PG8_SCHED __builtin_amdgcn_sched_barrier(0)
    Unit cur, nxt; int ui = 0;
    if (!S.next(0, cur)) return;
    f32x4 acc[2][2][4][2];
#pragma unroll
    for (int a = 0; a < 2; ++a)
#pragma unroll
        for (int b = 0; b < 2; ++b)
#pragma unroll
            for (int m = 0; m < 4; ++m)
#pragma unroll
                for (int n = 0; n < 2; ++n) acc[a][b][m][n] = (f32x4){0.f, 0.f, 0.f, 0.f};
    bf16x8 At[4][2], B0[2][2], B1[2][2];
    const char* cA = (const char*)g.A + (size_t)cur.pm * tstep; const char* cB = (const char*)g.Bt + (size_t)cur.pn * tstep;
    S.a_ready(cur);
    if constexpr (SP2) {
        PG8_STAGE(PG8_SB(0, 0), cB, voffB); PG8_STAGE(PG8_SB(0, 1), cB + hstep, voffB); PG8_STAGE(PG8_SA(0, 0), cA, voffA); PG8_STAGE(PG8_SA(0, 1), cA + hstep, voffA);
        if (wr == 1) PG8_BAR;
        PG8_WAIT_V(2); PG8_BAR;
        PG8_STAGE(PG8_SB(1, 0), cB + kstep, voffB); PG8_STAGE(PG8_SA(1, 0), cA + kstep, voffA); PG8_STAGE(PG8_SB(1, 1), cB + hstep + kstep, voffB);
        PG8_WAIT_V(6); PG8_BAR;
    } else {
        PG8_STAGE(PG8_SB(0, 0), cB, voffB); PG8_STAGE(PG8_SA(0, 0), cA, voffA); PG8_STAGE(PG8_SB(0, 1), cB + hstep, voffB); PG8_STAGE(PG8_SA(0, 1), cA + hstep, voffA);
        if (wr == 1) PG8_BAR;
        PG8_WAIT_V(4); PG8_BAR;
        PG8_STAGE(PG8_SB(1, 0), cB + kstep, voffB); PG8_STAGE(PG8_SA(1, 0), cA + kstep, voffA); PG8_STAGE(PG8_SB(1, 1), cB + hstep + kstep, voffB);
        PG8_WAIT_V(6); PG8_BAR;
    }
    for (;;) {
        const bool has_next = S.next(ui + 1, nxt);
        const char* nA = has_next ? (const char*)g.A + (size_t)nxt.pm * tstep : cA; const char* nB = has_next ? (const char*)g.Bt + (size_t)nxt.pn * tstep : cB;
        for (int t = 0; t < nt; t += 2) {
            const bool last = (t == nt - 2);
            const char* a1 = cA + (size_t)(t + 1) * kstep;
            const char* a2 = last ? nA : cA + (size_t)(t + 2) * kstep; const char* b2 = last ? nB : cB + (size_t)(t + 2) * kstep;
            const char* a3 = a2 + kstep; const char* b3 = b2 + kstep;
            if (last && has_next) S.a_ready(nxt);
            if constexpr (SP2) {
            PG8_LDB(B0, 0, 0); PG8_LDB(B1, 0, 1); PG8_SCHED; PG8_LDA(At, 0, 0); PG8_STAGE(PG8_SA(1, 1), a1 + hstep, voffA);
            PG8_WAIT_V(8); PG8_WAIT_L(0); PG8_BAR; PG8_MMA(0, 0, At, B0); PG8_MMA(0, 1, At, B1); PG8_BAR; PG8_SCHED;
            PG8_LDA(At, 0, 1); PG8_STAGE(PG8_SB(0, 0), b2, voffB); PG8_STAGE(PG8_SB(0, 1), b2 + hstep, voffB); PG8_STAGE(PG8_SA(0, 0), a2, voffA);
            PG8_WAIT_V(8); PG8_WAIT_L(0); PG8_BAR; PG8_MMA(1, 0, At, B0); PG8_MMA(1, 1, At, B1); PG8_BAR; PG8_SCHED;
            PG8_LDB(B0, 1, 0); PG8_LDB(B1, 1, 1); PG8_SCHED; PG8_LDA(At, 1, 0); PG8_STAGE(PG8_SA(0, 1), a2 + hstep, voffA);
            PG8_WAIT_V(8); PG8_WAIT_L(0); PG8_BAR; PG8_MMA(0, 0, At, B0); PG8_MMA(0, 1, At, B1); PG8_BAR; PG8_SCHED;
            PG8_LDA(At, 1, 1); PG8_STAGE(PG8_SB(1, 0), b3, voffB); PG8_STAGE(PG8_SB(1, 1), b3 + hstep, voffB); PG8_STAGE(PG8_SA(1, 0), a3, voffA);
            PG8_WAIT_V(8); PG8_WAIT_L(0); PG8_BAR; PG8_MMA(1, 0, At, B0); PG8_MMA(1, 1, At, B1); PG8_BAR; PG8_SCHED;
            } else {
            PG8_LDB(B0, 0, 0); PG8_SCHED; PG8_LDA(At, 0, 0); PG8_STAGE(PG8_SA(1, 1), a1 + hstep, voffA);
            PG8_WAIT_L(8); PG8_BAR; PG8_WAIT_L(0); PG8_MMA(0, 0, At, B0); PG8_BAR; PG8_SCHED;
            PG8_LDB(B1, 0, 1); PG8_STAGE(PG8_SB(0, 0), b2, voffB);
            PG8_BAR; PG8_WAIT_L(0); PG8_MMA(0, 1, At, B1); PG8_BAR;
            PG8_LDA(At, 0, 1); PG8_STAGE(PG8_SA(0, 0), a2, voffA);
            PG8_BAR; PG8_WAIT_L(0); PG8_MMA(1, 0, At, B0); PG8_BAR; PG8_SCHED;
            PG8_STAGE(PG8_SB(0, 1), b2 + hstep, voffB);
            PG8_WAIT_V(6); PG8_BAR; PG8_MMA(1, 1, At, B1); PG8_BAR;
            PG8_LDB(B0, 1, 0); PG8_SCHED; PG8_LDA(At, 1, 0); PG8_STAGE(PG8_SA(0, 1), a2 + hstep, voffA);
            PG8_WAIT_L(8); PG8_BAR; PG8_WAIT_L(0); PG8_MMA(0, 0, At, B0); PG8_BAR; PG8_SCHED;
            PG8_LDB(B1, 1, 1); PG8_STAGE(PG8_SB(1, 0), b3, voffB);
            PG8_BAR; PG8_WAIT_L(0); PG8_MMA(0, 1, At, B1); PG8_BAR;
            PG8_LDA(At, 1, 1); PG8_STAGE(PG8_SA(1, 0), a3, voffA);
            PG8_BAR; PG8_WAIT_L(0); PG8_MMA(1, 0, At, B0); PG8_BAR; PG8_SCHED;
            PG8_STAGE(PG8_SB(1, 1), b3 + hstep, voffB);
            PG8_WAIT_V(6); PG8_BAR; PG8_MMA(1, 1, At, B1); PG8_BAR;
            }
        }
        if constexpr (ALIGN_EPI) { if (wr == 0) PG8_BAR; }
        if constexpr (!Epi::AFTER_DRAIN) { E(acc, cur, wr, wc, fr, fq); S.done(cur); }
        if (!has_next) break;
#pragma unroll
        for (int a = 0; a < 2; ++a)
#pragma unroll
            for (int b = 0; b < 2; ++b)
#pragma unroll
                for (int m = 0; m < 4; ++m)
#pragma unroll
                    for (int n = 0; n < 2; ++n) acc[a][b][m][n] = (f32x4){0.f, 0.f, 0.f, 0.f};
        cur = nxt; cA = nA; cB = nB; ++ui;
        if constexpr (ALIGN_EPI) { if (wr == 1) PG8_BAR; }
    }
    PG8_WAIT_V(0);
    if constexpr (!ALIGN_EPI) { if (wr == 0) PG8_BAR; }
    PG8_BAR;
    if constexpr (Epi::AFTER_DRAIN) { E.fused(acc, cur, wr, wc, fr, fq, lds, wid, lane); S.done(cur); }
#undef PG8_SA
#undef PG8_SB
#undef PG8_STAGE
#undef PG8_LDA
#undef PG8_LDB
#undef PG8_MMA
#undef PG8_WAIT_V
#undef PG8_WAIT_L
#undef PG8_BAR
#undef PG8_SCHED
}
}

using pg8::bf16_t; using pg8::bf16x8; using pg8::f32x4; using pg8::u32x4; using pg8::u32x2;
using pg8::cvt_pk_bf16; using pg8::bflo; using pg8::bfhi; using pg8::fsigmoid; using pg8::fsilu;

#ifndef ONE_LAUNCH
#define ONE_LAUNCH 1
#define PROBE_SCAN_MASK 7
#define PROBE_SEG 0
#define PROBE_PREP 0
#define WGM_WIN 4
#define WGM_UP 4
#define WGM_N2K 4
#define PROBE_BAR 0

#endif

constexpr int DM = 2048, MROWS = 12288, NTHREADS = 512, NWAVES = 8;
constexpr int NINP = 18688, NIN = 18496;
constexpr int LDQ = 9216;
constexpr float EPS = 1e-6f;
constexpr float QSCALE = 0.08838834764831845f;

enum { I_XP = 0, I_XS, I_SC, I_SN, I_SM, I_SD, I_SR, I_C, I_CCTX, I_NORMG, I_FNG, I_WADA, I_BADA, I_WIN, I_BIN, I_FBIAS, I_CONVW, I_ALOG, I_DTB, I_LGAM, I_HNG, I_WBR, I_WOUT, I_W13, I_W2, N_INPUTS };

constexpr size_t OUT_Y = 0, OUT_C = 25165824, OUT_N = OUT_C + 8388608, OUT_M = OUT_N + 65536, OUT_DS = OUT_M + 512, OUT_RS = OUT_DS + 8388608, OUT_TOTAL = OUT_RS + 8388608;

constexpr size_t MiB = 1u << 20;
constexpr size_t WS_CTL = 0, CTL_BYTES = 2 * MiB;
constexpr size_t WS_QUEUE = 32768;
constexpr size_t WS_ADA = 65536;
constexpr size_t WS_SS = 512 * 1024;
constexpr size_t WS_SHW = 1 * MiB;
constexpr int SHW_LAYER = 105216, SHW_WIN = 24576, SHW_UP1 = 80640;
constexpr size_t WS_ROPE = 2 * MiB;
constexpr size_t WS_BIASP = WS_ROPE + 16384;
constexpr size_t WS_W13T = 3 * MiB;
constexpr size_t WS_W2T = WS_W13T + 64 * MiB;
constexpr size_t WS_WINT = WS_W2T + 32 * MiB;
constexpr size_t WS_WBRT = WS_WINT + 73 * MiB;
constexpr size_t WS_WOUTT = WS_WBRT + 12 * MiB;
constexpr size_t WS_PQ = WS_WOUTT + 8 * MiB;
constexpr size_t WS_PG = WS_PQ + 216 * MiB;
constexpr size_t WS_GT = WS_PG + 216 * MiB;
constexpr size_t WS_QN = WS_GT + 3 * MiB;
constexpr size_t WS_KT = WS_QN + 24 * MiB;
constexpr size_t WS_U0T = WS_KT + 24 * MiB;
constexpr size_t WS_WK = WS_U0T + 48 * MiB;
constexpr size_t WS_QKD = WS_WK + 48 * MiB;
constexpr size_t WS_GCH = WS_QKD + 24 * MiB;
constexpr size_t WS_HS = WS_GCH + 1 * MiB;
constexpr size_t WS_W1 = WS_HS + 144 * MiB;
constexpr size_t WS_BIASP1 = WS_W1 + 189 * MiB;
constexpr size_t WS_END = WS_BIASP1 + 1 * MiB;
__host__ __device__ constexpr size_t wofs(int l) { return l ? (WS_W1 - WS_W13T) : 0; }
constexpr size_t WS_HID = WS_PQ, WS_YS = WS_PQ, WS_TMP = WS_PQ + 76 * MiB, WS_H = WS_HS, WS_XB3 = WS_PQ + 100 * MiB;

constexpr int LDS_BYTES = 147456, LDS_WORK = LDS_BYTES - 64;

struct Params { const float* in[N_INPUTS]; float* out; unsigned char* ws; };

struct Frame { int tid, wid, lane, bid, G; LAS unsigned char* lds; unsigned char* ws; float* out; };

__device__ __forceinline__ int sp(int i, int dir) { return dir ? 63 - i : i; }
__device__ __forceinline__ f32x4 mfma16(bf16x8 a, bf16x8 b, f32x4 c) { return __builtin_amdgcn_mfma_f32_16x16x32_bf16(a, b, c, 0, 0, 0); }
template <int K> __device__ __forceinline__ f32x4 mm16(f32x4 acc, const LAS bf16_t* A, int lda, const LAS bf16_t* Bt, int ldb, int lane) {
    const int r = lane & 15, kq = (lane >> 4) * 8;
#pragma unroll
    for (int k0 = 0; k0 < K; k0 += 32) {
        const bf16x8 a = *(const LAS bf16x8*)(A + r * lda + k0 + kq);
        const bf16x8 b = *(const LAS bf16x8*)(Bt + r * ldb + k0 + kq);
        acc = mfma16(a, b, acc);
    }
    return acc;
}
__device__ __forceinline__ bf16_t f2bf(float f) { return (bf16_t)(cvt_pk_bf16(f, 0.f) & 0xffffu); }
__device__ __forceinline__ u32x2 pack4(f32x4 v) { u32x2 w; w.x = cvt_pk_bf16(v[0], v[1]); w.y = cvt_pk_bf16(v[2], v[3]); return w; }
__device__ __forceinline__ void unpack8(u32x4 w, float (&x)[8]) { x[0] = bflo(w.x); x[1] = bfhi(w.x); x[2] = bflo(w.y); x[3] = bfhi(w.y); x[4] = bflo(w.z); x[5] = bfhi(w.z); x[6] = bflo(w.w); x[7] = bfhi(w.w); }
__device__ __forceinline__ u32x4 pack8(const float (&x)[8]) { u32x4 w; w.x = cvt_pk_bf16(x[0], x[1]); w.y = cvt_pk_bf16(x[2], x[3]); w.z = cvt_pk_bf16(x[4], x[5]); w.w = cvt_pk_bf16(x[6], x[7]); return w; }
template <int CTRL, int ROWMASK> __device__ __forceinline__ float dppf(float old, float x) {
    return __builtin_bit_cast(float, __builtin_amdgcn_update_dpp(__builtin_bit_cast(int, old), __builtin_bit_cast(int, x), CTRL, ROWMASK, 0xF, false));
}
__device__ __forceinline__ float wave_scan_add(float x, int) {
    x += dppf<0x111, 0xF>(0.f, x); x += dppf<0x112, 0xF>(0.f, x); x += dppf<0x114, 0xF>(0.f, x); x += dppf<0x118, 0xF>(0.f, x);
    x += dppf<0x142, 0xA>(0.f, x); x += dppf<0x143, 0xC>(0.f, x);
    return x;
}
__device__ __forceinline__ float wave_scan_max(float x, int) {
    const float ninf = -__builtin_huge_valf();
    x = fmaxf(x, dppf<0x111, 0xF>(ninf, x)); x = fmaxf(x, dppf<0x112, 0xF>(ninf, x)); x = fmaxf(x, dppf<0x114, 0xF>(ninf, x)); x = fmaxf(x, dppf<0x118, 0xF>(ninf, x));
    x = fmaxf(x, dppf<0x142, 0xA>(ninf, x)); x = fmaxf(x, dppf<0x143, 0xC>(ninf, x));
    return x;
}

__device__ __forceinline__ float wave_sum(float s) {
#pragma unroll
    for (int o = 32; o >= 1; o >>= 1) s += __shfl_xor(s, o);
    return s;
}
__device__ __forceinline__ void phase_copy_norm(const Params& p, const Frame& f) {
    bf16_t* H = (bf16_t*)(f.ws + WS_H); float* SS = (float*)(f.ws + WS_SS);
    const float* g = p.in[I_NORMG]; const float* ada = (const float*)(f.ws + WS_ADA);
    for (int row = f.bid * NWAVES + f.wid; row < MROWS; row += f.G * NWAVES) {
        const int rb = row < 4096 ? 0 : (row < 8192 ? 1 : 2);
        const float* xs = (row < 4096) ? p.in[I_XP] + (size_t)row * 2048 : p.in[I_XS] + (size_t)(row - 4096) * 2048;
        const float* scl = ada + (size_t)(rb * 9 + 1) * 2048;
        f32x4 v[8]; float ss = 0.f;
#pragma unroll
        for (int it = 0; it < 8; ++it) { v[it] = *(const f32x4*)(xs + 4 * (f.lane + 64 * it)); ss += v[it][0] * v[it][0] + v[it][1] * v[it][1] + v[it][2] * v[it][2] + v[it][3] * v[it][3]; }
        ss = wave_sum(ss);
        if (f.lane == 0) SS[row] = ss;
#pragma unroll
        for (int it = 0; it < 8; ++it) { const int c = 4 * (f.lane + 64 * it);
            const f32x4 y = v[it] * *(const f32x4*)(g + c) * (*(const f32x4*)(scl + c) + 1.0f);
            *(u32x2*)(H + (size_t)row * 2048 + c) = pack4(y); }
    }
}
__device__ __forceinline__ void phase_rope(const Params& p, const Frame& f) {
    float* rope = (float*)(f.ws + WS_ROPE);
    for (int i = f.bid * NTHREADS + f.tid; i < 64 * 32; i += f.G * NTHREADS) {
        const int pos = i >> 5, fi = i & 31;
        const float freq = powf(10000.0f, -(float)fi / 32.0f), ang = (float)pos * freq;
        float s, c; sincosf(ang, &s, &c);
        rope[2 * i] = c; rope[2 * i + 1] = s;
    }
}
__device__ __forceinline__ void phase_ada(const Params& p, int l, int w, int nw, const Frame& f, int ilo = 0, int ihi = 9 * 128) {
    LAS float* sc = (LAS float*)f.lds;
    float* ada = (float*)(f.ws + WS_ADA);
#pragma unroll 1
    for (int item = ilo + w; item < ihi; item += nw) {
        const int g = item >> 7, kp = item & 127;
        __syncthreads();
        if (f.tid < 48) { const int r = f.tid >> 4, k = kp * 16 + (f.tid & 15);
            const float cv = (r == 0) ? p.in[I_CCTX][k] : p.in[I_C][(r - 1) * 2048 + k];
            sc[f.tid] = fsilu(cv); }
        __syncthreads();
        const int col = g * 2048 + f.tid * 4;
        const float* W = p.in[I_WADA] + ((size_t)l * 2048 + (size_t)kp * 16) * 18432 + col;
        f32x4 a0 = {0.f, 0.f, 0.f, 0.f}, a1 = a0, a2 = a0;
#pragma unroll
        for (int k = 0; k < 16; ++k) { const f32x4 w4 = *(const f32x4*)(W + (size_t)k * 18432); a0 += w4 * sc[k]; a1 += w4 * sc[16 + k]; a2 += w4 * sc[32 + k]; }
        if (kp == 0) { const f32x4 b = *(const f32x4*)(p.in[I_BADA] + (size_t)l * 18432 + col); a0 += b; a1 += b; a2 += b; }
        float* o = ada + (size_t)l * 3 * 18432 + col;
#pragma unroll
        for (int j = 0; j < 4; ++j) { atomicAdd(o + j, a0[j]); atomicAdd(o + 18432 + j, a1[j]); atomicAdd(o + 2 * 18432 + j, a2[j]); }
    }
}
__device__ __forceinline__ int win_src_col(int n) {
    if (n < 3072) return n;
    if (n < 6144) return 4128 + (n - 3072);
    if (n < 9216) return 8256 + (n - 6144);
    if (n < 10240) return 3072 + (n - 9216);
    if (n < 11264) return 7200 + (n - 10240);
    if (n < 12288) return 11328 + (n - 11264);
    if (n < 18432) return 12352 + (n - 12288);
    if (n < 18464) return 4096 + (n - 18432);
    if (n < 18496) return 8224 + (n - 18464);
    return -1;
}
__device__ __forceinline__ void convert_bias(const Params& p, int l, int first, int stride, const Frame& f) {
    float* biasp = (float*)(f.ws + (l ? WS_BIASP1 : WS_BIASP));
    for (int i = first * NTHREADS + f.tid; i < NINP; i += stride * NTHREADS) { const int s = win_src_col(i); biasp[i] = (s >= 0) ? p.in[I_BIN][(size_t)l * NIN + s] : 0.f; }
}
__device__ __forceinline__ void convert_item(const Params& p, int l, int item, const Frame& f) {
    {
        const size_t wo = wofs(l);
        const float* src; bf16_t* dst; int K, Nsrc, nb, kb, kind; const float* shp = nullptr; float* shd = nullptr; int shn = 0;
        if (item < 512) { const int j = item >> 8, r = item & 255; nb = r >> 1; kb = r & 1; K = 2048; Nsrc = 8192; kind = 0;
            src = p.in[I_W13] + (size_t)(l * 2 + j) * 2048 * 8192; dst = (bf16_t*)(f.ws + wo + WS_W13T) + (size_t)j * 8192 * 2048;
            shp = (const float*)(f.ws + WS_ADA) + (size_t)l * 3 * 18432 + (size_t)(j == 0 ? 0 : 6) * 2048; shd = (float*)(f.ws + WS_SHW) + (size_t)l * SHW_LAYER + (j == 0 ? 0 : SHW_UP1); shn = 8192; }
        else if (item < 768) { const int it = item - 512, j = it >> 7, r = it & 127; nb = r >> 2; kb = r & 3; K = 4096; Nsrc = 2048; kind = 1;
            src = p.in[I_W2] + (size_t)(l * 2 + j) * 4096 * 2048; dst = (bf16_t*)(f.ws + wo + WS_W2T) + (size_t)j * 2048 * 4096; }
        else if (item < 1352) { const int it = item - 768; nb = it >> 1; kb = it & 1; K = 2048; Nsrc = NIN; kind = 2;
            src = p.in[I_WIN] + (size_t)l * 2048 * NIN; dst = (bf16_t*)(f.ws + wo + WS_WINT);
            shp = (const float*)(f.ws + WS_ADA) + (size_t)l * 3 * 18432 + (size_t)3 * 2048; shd = (float*)(f.ws + WS_SHW) + (size_t)l * SHW_LAYER + SHW_WIN; shn = NINP; }
        else if (item < 1448) { const int it = item - 1352, j = it >> 5; nb = it & 31; kb = 0; K = 1024; Nsrc = 2048; kind = 1;
            src = p.in[I_WBR] + (size_t)(l * 3 + j) * 1024 * 2048; dst = (bf16_t*)(f.ws + wo + WS_WBRT) + (size_t)j * 2048 * 1024; }
        else { const int it = item - 1448; nb = it >> 1; kb = it & 1; K = 2048; Nsrc = 2048; kind = 1;
            src = p.in[I_WOUT] + (size_t)l * 2048 * 2048; dst = (bf16_t*)(f.ws + wo + WS_WOUTT); }
        const int nd = nb * 64 + f.lane;
        int scol;
        if (kind == 0) scol = ((nd >> 7) & 1) * 4096 + (nd >> 8) * 128 + (nd & 127);
        else if (kind == 1) scol = nd;
        else scol = win_src_col(nd);
        const int k0 = kb * 1024 + f.wid * 128;
        const float* sp0 = src + (size_t)k0 * Nsrc + (scol >= 0 ? scol : 0);
        bf16_t* dp = dst + (size_t)nd * K + k0;
        float dsh0 = 0.f, dsh1 = 0.f, dsh2 = 0.f;
#pragma unroll 1
        for (int kk = 0; kk < 128; kk += 64) {
            float v[64];
#pragma unroll
            for (int j = 0; j < 64; ++j) v[j] = sp0[(size_t)(kk + j) * Nsrc];
            if (scol < 0) {
#pragma unroll
                for (int j = 0; j < 64; ++j) v[j] = 0.f; }
            if (shp) { const float* s0 = shp + k0 + kk; const float* s1 = s0 + 9 * 2048; const float* s2 = s1 + 9 * 2048;
#pragma unroll
                for (int j = 0; j < 64; ++j) { dsh0 += v[j] * s0[j]; dsh1 += v[j] * s1[j]; dsh2 += v[j] * s2[j]; } }
#pragma unroll
            for (int q = 0; q < 8; ++q) {
                u32x4 w;
                w.x = cvt_pk_bf16(v[8 * q + 0], v[8 * q + 1]); w.y = cvt_pk_bf16(v[8 * q + 2], v[8 * q + 3]); w.z = cvt_pk_bf16(v[8 * q + 4], v[8 * q + 5]); w.w = cvt_pk_bf16(v[8 * q + 6], v[8 * q + 7]);
                *(u32x4*)(dp + kk + 8 * q) = w;
            }
        }
        if (shp && scol >= 0) { atomicAdd(shd + nd, dsh0); atomicAdd(shd + shn + nd, dsh1); atomicAdd(shd + 2 * shn + nd, dsh2); }
    }
}
constexpr int CONV_ITEMS = 1512;
__device__ __forceinline__ void convert_range(const Params& p, int l, int lo, int hi, int w, int nw, const Frame& f) {
#pragma unroll 1
    for (int item = lo + w; item < hi; item += nw) convert_item(p, l, item, f);
}
__device__ __forceinline__ void convert_first_set(const Params& p, int l, int w, int nw, const Frame& f) {
    convert_bias(p, l, w, nw, f);
    convert_range(p, l, 0, 256, w, nw, f); convert_range(p, l, 512, 640, w, nw, f);
    if (l != 0) convert_range(p, l, 1280, 1352, w, nw, f);
}
__device__ __forceinline__ void convert_fill(const Params& p, int l, int slot, const Frame& f) {
    if (f.G != 256) return;
    if (slot == 6) { if (f.bid >= 176) convert_range(p, l, 1352, 1512, f.bid - 176, 80, f); return; }
    if (f.bid < 128) return;
    const int w = f.bid - 128;
    if (slot == 0) convert_range(p, l, 768, l == 0 ? 1352 : 1280, w, 128, f);
    else if (slot == 1) convert_range(p, l, 256, 384, w, 128, f);
    else if (slot == 2) convert_range(p, l, 384, 512, w, 128, f);
    else if (slot == 3) { if (l == 0) phase_ada(p, 1, w, 128, f); }
    else if (slot == 4) convert_range(p, l, 640, 768, w, 128, f);
    else if (slot == 5 && l == 0) convert_first_set(p, 1, w, 128, f);
}
__device__ __forceinline__ void phase_convert(const Params& p, int l, const Frame& f) {
    if (f.G == 256) { if (l == 0) convert_first_set(p, 0, f.bid, f.G, f); }
    else { convert_bias(p, l, f.bid, f.G, f); convert_range(p, l, 0, CONV_ITEMS, f.bid, f.G, f); }
}

__device__ __forceinline__ void phase_final_norm(const Params& p, const Frame& f) {
    float* X = f.out + OUT_Y; const float* g = p.in[I_FNG]; const float* SS = (const float*)(f.ws + WS_SS) + (size_t)6 * MROWS;
    const size_t n = (size_t)MROWS * 512, stride = (size_t)f.G * NTHREADS;
    for (size_t i0 = (size_t)f.bid * NTHREADS + f.tid; i0 < n; i0 += 4 * stride) {
        f32x4 x[4]; float rs[4];
#pragma unroll
        for (int k = 0; k < 4; ++k) { const size_t i = i0 + k * stride; if (i < n) { x[k] = *(const f32x4*)(X + (i >> 9) * 2048 + (i & 511) * 4); rs[k] = SS[i >> 9]; } }
#pragma unroll
        for (int k = 0; k < 4; ++k) { const size_t i = i0 + k * stride; if (i < n) { const int c = (int)(i & 511) * 4;
            *(f32x4*)(X + (i >> 9) * 2048 + c) = x[k] * rsqrtf(rs[k] * (1.0f / 2048.0f) + EPS) * *(const f32x4*)(g + c); } }
    }
}

__device__ __forceinline__ void phase_merge(const Params& p, int l, const Frame& f) {
    const bf16_t* HS = (const bf16_t*)(f.ws + WS_HS); const bf16_t* PG = (const bf16_t*)(f.ws + WS_PG); bf16_t* YS = (bf16_t*)(f.ws + WS_YS);
    const float* hng = p.in[I_HNG] + (size_t)l * 3 * 128;
    for (int row = f.bid * NWAVES + f.wid; row < MROWS; row += f.G * NWAVES) {
        const int c0 = 16 * f.lane;
        u32x4 rf[3][2], rbk[3][2], rg[3][2];
#pragma unroll
        for (int mx = 0; mx < 3; ++mx) {
            const bf16_t* pf = HS + ((size_t)(mx * 2 + 0) * MROWS + row) * 1024 + c0;
            const bf16_t* pb = HS + ((size_t)(mx * 2 + 1) * MROWS + row) * 1024 + c0;
            const bf16_t* pgt = PG + (size_t)row * LDQ + mx * 1024 + c0;
            rf[mx][0] = *(const u32x4*)pf; rf[mx][1] = *(const u32x4*)(pf + 8); rbk[mx][0] = *(const u32x4*)pb; rbk[mx][1] = *(const u32x4*)(pb + 8);
            rg[mx][0] = *(const u32x4*)pgt; rg[mx][1] = *(const u32x4*)(pgt + 8);
        }
#pragma unroll
        for (int mx = 0; mx < 3; ++mx) {
            float a[8], b[8], s[16], gt[16];
            unpack8(rf[mx][0], a); unpack8(rbk[mx][0], b);
#pragma unroll
            for (int j = 0; j < 8; ++j) s[j] = a[j] + b[j];
            unpack8(rf[mx][1], a); unpack8(rbk[mx][1], b);
#pragma unroll
            for (int j = 0; j < 8; ++j) s[8 + j] = a[j] + b[j];
            unpack8(rg[mx][0], a); unpack8(rg[mx][1], b);
#pragma unroll
            for (int j = 0; j < 8; ++j) { gt[j] = a[j]; gt[8 + j] = b[j]; }
            float ss = 0.f;
#pragma unroll
            for (int j = 0; j < 16; ++j) ss += s[j] * s[j];
            ss += __shfl_xor(ss, 1); ss += __shfl_xor(ss, 2); ss += __shfl_xor(ss, 4);
            const float rs = rsqrtf(ss * (1.0f / 128.0f) + EPS);
            const float* hg = hng + mx * 128 + (c0 & 127);
            float o[8];
#pragma unroll
            for (int j = 0; j < 8; ++j) o[j] = s[j] * rs * hg[j] * gt[j];
            bf16_t* po = YS + ((size_t)mx * MROWS + row) * 1024 + c0;
            *(u32x4*)po = pack8(o);
#pragma unroll
            for (int j = 0; j < 8; ++j) o[j] = s[8 + j] * rs * hg[8 + j] * gt[8 + j];
            *(u32x4*)(po + 8) = pack8(o);
        }
    }
}

constexpr int PA = 144, PB = 80;
typedef short v4i16_t __attribute__((ext_vector_type(4)));
__device__ __forceinline__ bf16x8 rd_frag(const LAS bf16_t* X, int pitch, int row0, int k0, int lane) {
    return *(const LAS bf16x8*)(X + (row0 + (lane & 15)) * pitch + k0 + 8 * (lane >> 4));
}
__device__ __forceinline__ bf16x8 tr_frag(const LAS bf16_t* X, int pitch, int t0, int c0, int lane) {
    const LAS bf16_t* a = X + (t0 + 8 * (lane >> 4) + ((lane & 15) >> 2)) * pitch + c0 + 4 * (lane & 3);
    const v4i16_t lo = __builtin_amdgcn_ds_read_tr16_b64_v4i16((LAS v4i16_t*)a);
    const v4i16_t hi = __builtin_amdgcn_ds_read_tr16_b64_v4i16((LAS v4i16_t*)(a + 4 * pitch));
    bf16x8 f; f[0] = lo[0]; f[1] = lo[1]; f[2] = lo[2]; f[3] = lo[3]; f[4] = hi[0]; f[5] = hi[1]; f[6] = hi[2]; f[7] = hi[3];
    return f;
}

constexpr int PR_KN = 0, PR_V = 18432, PR_ASC = 36864, PR_KK = 69632, PR_QN = 86272, PR_T1 = 69632, PR_T2 = 90112, PR_GS = 110592, PR_BS = 111104,
              PR_TU = 111616, PR_A21 = 121856, PR_XT = 126976, PR_CW = 132096, PR_END = 136704,
              PR_AD = 36864, PR_A21S = 45056, PR_T22S = 50176, PR_XTS = 55296;
static_assert(PR_END <= LDS_BYTES - 64, "prep LDS map");
struct PrepLoads { u32x4 r[3][6]; float gb, ga; };
__device__ __forceinline__ void prep_issue_loads(PrepLoads& L, const bf16_t* PQ, const float* GT, int item, int tid, int lane, int wid) {
    const int gc = item >> 3, h = item & 7, row0 = gc * 64;
    const bool first = (gc < 64) ? ((gc & 3) == 0) : (((gc - 64) & 63) == 0);
    const bool last = (gc < 64) ? ((gc & 3) == 3) : (((gc - 64) & 63) == 63);
    const int i = tid >> 3, s = tid & 7, row = row0 + i;
    const bool okm = (i > 0) || !first, okp = (i < 63) || !last;
    const u32x4 z = {0u, 0u, 0u, 0u};
#pragma unroll
    for (int X = 0; X < 3; ++X) {
        const bf16_t* src = PQ + (size_t)row * LDQ + 3072 + X * 1024 + h * 128 + 8 * s;
        L.r[X][0] = okm ? *(const u32x4*)(src - LDQ) : z; L.r[X][1] = *(const u32x4*)src; L.r[X][2] = okp ? *(const u32x4*)(src + LDQ) : z;
        L.r[X][3] = okm ? *(const u32x4*)(src - LDQ + 64) : z; L.r[X][4] = *(const u32x4*)(src + 64); L.r[X][5] = okp ? *(const u32x4*)(src + LDQ + 64) : z;
    }
    L.gb = 0.f; L.ga = 0.f;
    if (wid < 2) { const int dir = wid, r2 = row0 + sp(lane, dir); L.gb = GT[(size_t)r2 * 64 + 32 + dir * 8 + h]; L.ga = GT[(size_t)r2 * 64 + 48 + dir * 8 + h]; }
}
__device__ __forceinline__ void phase_delta_prep(const Params& p, int l, const Frame& f) {
    LAS bf16_t* kn = (LAS bf16_t*)(f.lds + PR_KN); LAS bf16_t* vv = (LAS bf16_t*)(f.lds + PR_V); LAS bf16_t* qn = (LAS bf16_t*)(f.lds + PR_QN);
    LAS float* KK = (LAS float*)(f.lds + PR_KK); LAS float* Ad = (LAS float*)(f.lds + PR_AD);
    LAS bf16_t* A21s = (LAS bf16_t*)(f.lds + PR_A21S); LAS bf16_t* T22s = (LAS bf16_t*)(f.lds + PR_T22S); LAS bf16_t* XTs = (LAS bf16_t*)(f.lds + PR_XTS);
    LAS float* Gs = (LAS float*)(f.lds + PR_GS); LAS float* bs = (LAS float*)(f.lds + PR_BS);
    LAS bf16_t* T1 = (LAS bf16_t*)(f.lds + PR_T1); LAS bf16_t* T2 = (LAS bf16_t*)(f.lds + PR_T2);
    LAS bf16_t* TU = (LAS bf16_t*)(f.lds + PR_TU); LAS bf16_t* A21 = (LAS bf16_t*)(f.lds + PR_A21); LAS bf16_t* XT = (LAS bf16_t*)(f.lds + PR_XT);
    const bf16_t* PQ = (const bf16_t*)(f.ws + WS_PQ); const float* GT = (const float*)(f.ws + WS_GT);
    bf16_t* QN = (bf16_t*)(f.ws + WS_QN); bf16_t* KNg = (bf16_t*)(f.ws + WS_KT); bf16_t* U0T = (bf16_t*)(f.ws + WS_U0T); bf16_t* WKg = (bf16_t*)(f.ws + WS_WK);
    bf16_t* QKD = (bf16_t*)(f.ws + WS_QKD); float* GCH = (float*)(f.ws + WS_GCH);
    const float* convw = p.in[I_CONVW] + (size_t)l * 3 * 3072;
    const int wid = f.wid;
    PrepLoads L;
    if (f.bid < 192 * 8) prep_issue_loads(L, PQ, GT, f.bid, f.tid, f.lane, wid);
    LAS float* cw = (LAS float*)(f.lds + PR_CW);
    for (int i = f.tid; i < (PR_XTS + 5120 - PR_A21S) / 4; i += NTHREADS) ((LAS unsigned*)(f.lds + PR_A21S))[i] = 0u;
    for (int i = f.tid; i < 10240 / 4; i += NTHREADS) ((LAS unsigned*)(f.lds + PR_TU))[i] = 0u;
    int hcur = -1;
#pragma unroll 1
    for (int item = f.bid; item < 192 * 8; item += f.G) {
        const int gc = item >> 3, h = item & 7, row0 = gc * 64, ch = gc * 8 + h;
        int tid = f.tid; asm volatile("" : "+v"(tid));
        const int lane = tid & 63;
        __syncthreads();
        if (h != hcur) {
            for (int i = f.tid; i < 3 * 384; i += NTHREADS) { const int tap = i / 384, c = i % 384; cw[i] = convw[tap * 3072 + (c >> 7) * 1024 + h * 128 + (c & 127)]; }
            hcur = h;
            __syncthreads();
        }
        {
            const int i = tid >> 3, s = tid & 7, row = row0 + i;
#pragma unroll
            for (int X = 0; X < 3; ++X) {
                const int cb = X * 1024 + h * 128 + 8 * s;
                float o1[8], o2[8];
                {
                    float xm[8], x0[8], xp[8];
                    unpack8(L.r[X][0], xm); unpack8(L.r[X][1], x0); unpack8(L.r[X][2], xp);
                    const LAS float* w = cw + X * 128 + 8 * s;
#pragma unroll
                    for (int j = 0; j < 8; ++j) o1[j] = fsilu(xm[j] * w[j] + x0[j] * w[384 + j] + xp[j] * w[768 + j]);
                    unpack8(L.r[X][3], xm); unpack8(L.r[X][4], x0); unpack8(L.r[X][5], xp);
#pragma unroll
                    for (int j = 0; j < 8; ++j) o2[j] = fsilu(xm[j] * w[64 + j] + x0[j] * w[384 + 64 + j] + xp[j] * w[768 + 64 + j]);
                }
                if (X < 2) {
                    float ss = 0.f;
#pragma unroll
                    for (int j = 0; j < 8; ++j) ss += o1[j] * o1[j] + o2[j] * o2[j];
                    ss += __shfl_xor(ss, 1); ss += __shfl_xor(ss, 2); ss += __shfl_xor(ss, 4);
                    const float scl = rsqrtf(ss + EPS) * (X == 0 ? QSCALE : 1.0f);
#pragma unroll
                    for (int j = 0; j < 8; ++j) { o1[j] *= scl; o2[j] *= scl; }
                }
                const u32x4 w1 = pack8(o1), w2 = pack8(o2);
                LAS bf16_t* T = (X == 0) ? qn : ((X == 1) ? kn : vv);
                *(LAS u32x4*)(T + i * PA + 8 * s) = w1; *(LAS u32x4*)(T + i * PA + 64 + 8 * s) = w2;
                if (X < 2) { bf16_t* g = ((X == 0) ? QN : KNg) + (size_t)row * 1024 + h * 128 + 8 * s; *(u32x4*)g = w1; *(u32x4*)(g + 64) = w2; }
            }
        }
        if (wid < 2) {
            const int dir = wid, i = sp(lane, dir);
            const float be = fsigmoid(L.gb);
            const float xa = L.ga + p.in[I_DTB][(l * 2 + dir) * 8 + h];
            const float spl = (xa > 20.f) ? xa : __logf(1.0f + __expf(xa));
            const float g = -__expf(p.in[I_ALOG][(l * 2 + dir) * 8 + h]) * spl;
            const float G = wave_scan_add(g, lane);
            Gs[dir * 64 + i] = G; bs[dir * 64 + i] = be;
            GCH[(size_t)(ch * 2 + dir) * 64 + i] = G;
        }
        if (item + f.G < 192 * 8) prep_issue_loads(L, PQ, GT, item + f.G, tid, lane, wid);
        __syncthreads();
#pragma unroll
        for (int t2 = 0; t2 < 2; ++t2) {
            const int tt = 2 * wid + t2, tm = tt >> 2, tn = tt & 3;
            f32x4 akk = {0.f, 0.f, 0.f, 0.f}, aqk = akk;
#pragma unroll
            for (int ks = 0; ks < 4; ++ks) {
                const bf16x8 a = rd_frag(kn, PA, 16 * tm, 32 * ks, lane);
                akk = mfma16(a, rd_frag(kn, PA, 16 * tn, 32 * ks, lane), akk);
                aqk = mfma16(a, rd_frag(qn, PA, 16 * tn, 32 * ks, lane), aqk);
            }
            const int r0 = 16 * tm + 4 * (lane >> 4), cc = 16 * tn + (lane & 15);
#pragma unroll
            for (int r = 0; r < 4; ++r) KK[(r0 + r) * 65 + cc] = akk[r];
#pragma unroll
            for (int dir = 0; dir < 2; ++dir) {
                const float Gi = Gs[dir * 64 + cc]; const int pi = sp(cc, dir);
                f32x4 v;
#pragma unroll
                for (int r = 0; r < 4; ++r) { const int j = r0 + r; const float e = aqk[r] * __expf(fminf(Gi - Gs[dir * 64 + j], 0.f)); v[r] = (sp(j, dir) <= pi) ? e : 0.f; }
                *(u32x2*)(QKD + (size_t)(ch * 2 + dir) * 4096 + cc * 64 + r0) = pack4(v);
            }
        }
        __syncthreads();
#pragma unroll 4
        for (int it = 0; it < 8; ++it) {
            const int e = tid + 512 * it, dir = e >> 11, kk = (e >> 6) & 31, sl = e & 63;
            const int pp = (sl < kk) ? kk : 63 - kk, p2 = (sl < kk) ? sl : sl - kk;
            if (p2 < pp) {
                const int i = sp(pp, dir), j = sp(p2, dir);
                const float a = bs[dir * 64 + i] * KK[i * 65 + j] * __expf(fminf(Gs[dir * 64 + i] - Gs[dir * 64 + j], 0.f));
                if (pp >= 32 && p2 < 32) A21[(dir * 32 + (pp - 32)) * 40 + p2] = f2bf(a);
                else if ((pp >> 4) == (p2 >> 4)) Ad[((dir * 4 + (pp >> 4)) * 16 + (pp & 15)) * 16 + (p2 & 15)] = a;
                else A21s[((dir * 2 + (pp >> 5)) * 16 + (pp & 15)) * 40 + (p2 & 15)] = f2bf(a);
            }
        }
        __syncthreads();
        {
            const int dir = wid >> 2, d16 = wid & 3, b = d16 >> 1, half = d16 & 1, c = lane & 15;
            const LAS float* A = Ad + (dir * 4 + d16) * 256;
            const int jn = sp(16 * d16 + c, dir); const float bj = bs[dir * 64 + jn], bg = bj * __expf(Gs[dir * 64 + jn]);
            LAS bf16_t* t1p = T1 + (dir * 64 + 16 * d16) * PB + jn; LAS bf16_t* t2p = T2 + (dir * 64 + 16 * d16) * PB + jn;
            LAS bf16_t* tup = TU + ((dir * 2 + b) * 32 + 16 * half) * 40 + 16 * half + c;
            LAS bf16_t* t22p = T22s + ((dir * 2 + b) * 16) * 40 + c;
            const int bc = d16 + (lane >> 4); const int jz = sp((16 * bc + c) & 63, dir);
            LAS bf16_t* z1p = T1 + (dir * 64 + 16 * d16) * PB + jz; LAS bf16_t* z2p = T2 + (dir * 64 + 16 * d16) * PB + jz;
            const bool wl = lane < 16, zl = (lane >= 16) && (bc <= 3);
            float ar[16];
#pragma unroll
            for (int r = 0; r < 16; ++r) ar[r] = A[r * 16 + c];
            float t[16];
#pragma unroll
            for (int r = 0; r < 16; ++r) {
                float ac[4] = {(r == c) ? 1.f : 0.f, 0.f, 0.f, 0.f};
#pragma unroll
                for (int j = 0; j < r; ++j) {
                    const float aj = __builtin_bit_cast(float, __builtin_amdgcn_readlane(__builtin_bit_cast(int, ar[r]), j));
                    ac[j & 3] -= aj * t[j];
                }
                const float acc = (ac[0] + ac[1]) + (ac[2] + ac[3]);
                t[r] = acc;
                if (wl) { t1p[r * PB] = f2bf(acc * bj); t2p[r * PB] = f2bf(acc * bg); tup[r * 40] = f2bf(acc); if (half) t22p[r * 40] = f2bf(acc); }
                if (zl) { z1p[r * PB] = (bf16_t)0; z2p[r * PB] = (bf16_t)0; }
            }
        }
        __syncthreads();
        if (wid < 4) {
            const int dir = wid >> 1, b = wid & 1;
            const LAS bf16_t* a21s = A21s + (dir * 2 + b) * 16 * 40; const LAS bf16_t* t22s = T22s + (dir * 2 + b) * 16 * 40;
            LAS bf16_t* tub = TU + (dir * 2 + b) * 32 * 40; LAS bf16_t* xts = XTs + (dir * 2 + b) * 16 * 40;
            f32x4 x = {0.f, 0.f, 0.f, 0.f};
            x = mfma16(rd_frag(a21s, 40, 0, 0, lane), tr_frag(tub, 40, 0, 0, lane), x);
            *(LAS u32x2*)(xts + (lane & 15) * 40 + 4 * (lane >> 4)) = pack4(x);
            f32x4 y = {0.f, 0.f, 0.f, 0.f};
            y = mfma16(rd_frag(t22s, 40, 0, 0, lane), rd_frag(xts, 40, 0, 0, lane), y);
            const int n = lane & 15, m0 = 4 * (lane >> 4);
            const int jn = sp(32 * b + n, dir); const float bj = bs[dir * 64 + jn], bg = bj * __expf(Gs[dir * 64 + jn]);
#pragma unroll
            for (int r = 0; r < 4; ++r) {
                const int pp = 32 * b + 16 + m0 + r;
                tub[(16 + m0 + r) * 40 + n] = f2bf(-y[r]);
                T1[(dir * 64 + pp) * PB + jn] = f2bf(-y[r] * bj); T2[(dir * 64 + pp) * PB + jn] = f2bf(-y[r] * bg);
            }
        }
        __syncthreads();
        if (wid < 2) {
            const int dir = wid;
            const LAS bf16_t* a21 = A21 + dir * 32 * 40; const LAS bf16_t* tu11 = TU + (dir * 2) * 32 * 40; LAS bf16_t* xt = XT + dir * 32 * 40;
            const LAS bf16_t* tu22 = TU + (dir * 2 + 1) * 32 * 40;
#pragma unroll
            for (int tm = 0; tm < 2; ++tm)
#pragma unroll
                for (int tn = 0; tn < 2; ++tn) {
                    f32x4 x = {0.f, 0.f, 0.f, 0.f};
                    x = mfma16(rd_frag(a21, 40, 16 * tm, 0, lane), tr_frag(tu11, 40, 0, 16 * tn, lane), x);
                    *(LAS u32x2*)(xt + (16 * tn + (lane & 15)) * 40 + 16 * tm + 4 * (lane >> 4)) = pack4(x);
                }
#pragma unroll
            for (int tm = 0; tm < 2; ++tm)
#pragma unroll
                for (int tn = 0; tn < 2; ++tn) {
                    f32x4 y = {0.f, 0.f, 0.f, 0.f};
                    y = mfma16(rd_frag(tu22, 40, 16 * tm, 0, lane), rd_frag(xt, 40, 16 * tn, 0, lane), y);
                    const int jn = sp(16 * tn + (lane & 15), dir); const float bj = bs[dir * 64 + jn], bg = bj * __expf(Gs[dir * 64 + jn]);
                    const int pp0 = 32 + 16 * tm + 4 * (lane >> 4);
#pragma unroll
                    for (int r = 0; r < 4; ++r) { T1[(dir * 64 + pp0 + r) * PB + jn] = f2bf(-y[r] * bj); T2[(dir * 64 + pp0 + r) * PB + jn] = f2bf(-y[r] * bg); }
                }
        }
        __syncthreads();
        {
            const int dir = wid >> 2, sub = wid & 3;
            bf16_t* u0 = U0T + (size_t)(ch * 2 + dir) * 8192; bf16_t* wk = WKg + (size_t)(ch * 2 + dir) * 8192;
            const bf16x8 a0 = rd_frag(T1 + dir * 64 * PB, PB, 16 * sub, 0, lane), a1 = rd_frag(T1 + dir * 64 * PB, PB, 16 * sub, 32, lane);
            const bf16x8 b0 = rd_frag(T2 + dir * 64 * PB, PB, 16 * sub, 0, lane), b1 = rd_frag(T2 + dir * 64 * PB, PB, 16 * sub, 32, lane);
#pragma unroll 2
            for (int tn = 0; tn < 8; ++tn) {
                f32x4 a = {0.f, 0.f, 0.f, 0.f}, b = a;
                a = mfma16(a0, tr_frag(vv, PA, 0, 16 * tn, lane), a); a = mfma16(a1, tr_frag(vv, PA, 32, 16 * tn, lane), a);
                {
                    const int pp0 = 16 * sub + 4 * (lane >> 4);
                    f32x4 ar; ar[0] = a[3]; ar[1] = a[2]; ar[2] = a[1]; ar[3] = a[0];
                    *(u32x2*)(u0 + (16 * tn + (lane & 15)) * 64 + (dir ? 60 - pp0 : pp0)) = pack4(dir ? ar : a);
                }
                b = mfma16(tr_frag(kn, PA, 0, 16 * tn, lane), b0, b); b = mfma16(tr_frag(kn, PA, 32, 16 * tn, lane), b1, b);
                *(u32x2*)(wk + sp(16 * sub + (lane & 15), dir) * 128 + 16 * tn + 4 * (lane >> 4)) = pack4(b);
            }
        }
    }
}

struct SeqInfo { int rowbase, NC, b; bool samp; };
__device__ __forceinline__ SeqInfo seq_info(int seq) { SeqInfo s; s.samp = seq >= 16; s.NC = s.samp ? 64 : 4; s.b = s.samp ? seq - 16 : seq; s.rowbase = s.samp ? 4096 + (seq - 16) * 4096 : seq * 256; return s; }
__device__ __forceinline__ size_t state_index(int b, int l, int dir, int h) { return (size_t)(((b * 2 + l) * 2 + dir) * 8 + h); }

__device__ __forceinline__ void state_load(f32x4 (&acc)[4], const float* src, int eh, LAS bf16_t* ST, const Frame& f) {
    const int d0 = 16 * f.wid + 4 * (f.lane >> 4), e0 = f.lane & 15;
#pragma unroll
    for (int te = 0; te < 4; ++te) {
        f32x4 v = {0.f, 0.f, 0.f, 0.f};
        if (src) {
#pragma unroll
            for (int r = 0; r < 4; ++r) v[r] = src[(size_t)(d0 + r) * 128 + 64 * eh + 16 * te + e0]; }
        acc[te] = v;
        *(LAS u32x2*)(ST + (16 * te + e0) * PA + d0) = pack4(v);
    }
}
__device__ __forceinline__ void state_store(const f32x4 (&acc)[4], float* dst, int eh, const Frame& f) {
    const int d0 = 16 * f.wid + 4 * (f.lane >> 4), e0 = f.lane & 15;
#pragma unroll
    for (int te = 0; te < 4; ++te)
#pragma unroll
        for (int r = 0; r < 4; ++r) dst[(size_t)(d0 + r) * 128 + 64 * eh + 16 * te + e0] = acc[te][r];
}

constexpr int SC_Q = 0, SC_K = 18432, SC_K2 = 36864, SC_V = 55296, SC_P = 65536, SC_ST = 75776, SC_VEC = 94208;

__device__ __forceinline__ void ret_item(const Params& p, int l, int seq, int h, int dir, int eh, unsigned* qnext, const Frame& f) {
    LAS bf16_t* q = (LAS bf16_t*)(f.lds + SC_Q); LAS bf16_t* ke = (LAS bf16_t*)(f.lds + SC_K); LAS bf16_t* vv = (LAS bf16_t*)(f.lds + SC_V);
    LAS bf16_t* P = (LAS bf16_t*)(f.lds + SC_P); LAS bf16_t* ST = (LAS bf16_t*)(f.lds + SC_ST);
    const bf16_t* PQ = (const bf16_t*)(f.ws + WS_PQ); const float* rope = (const float*)(f.ws + WS_ROPE);
    bf16_t* HS = (bf16_t*)(f.ws + WS_HS) + (size_t)(2 * 2 + dir) * MROWS * 1024;
    const SeqInfo si = seq_info(seq);
    const int tid = f.tid, lane = f.lane, wid = f.wid;
    const float lg = p.in[I_LGAM][(l * 2 + dir) * 8 + h];
    const size_t sidx = state_index(si.b, l, dir, h);
    f32x4 accS[4];
    __syncthreads();
    state_load(accS, si.samp ? p.in[I_SR] + sidx * 16384 : nullptr, eh, ST, f);
    const float cdec = __expf(lg * 64.0f);
    const int si_i = tid >> 3, si_s = tid & 7;
    u32x4 rq1, rq2, rk1, rk2, rv; f32x4 rcs[4];
    const int rope_f0 = (si_s < 4) ? 8 * si_s : 8 * si_s - 32;
    {
        const int cn = dir ? si.NC - 1 : 0;
        { const f32x4* cs4 = (const f32x4*)(rope + (size_t)(((si_s < 4) ? cn : si_i) * 32 + rope_f0) * 2); rcs[0] = cs4[0]; rcs[1] = cs4[1]; rcs[2] = cs4[2]; rcs[3] = cs4[3]; }
        const bf16_t* src = PQ + (size_t)(si.rowbase + 64 * cn + si_i) * LDQ + h * 128 + 8 * si_s;
        rq1 = *(const u32x4*)(src + 6144); rq2 = *(const u32x4*)(src + 6144 + 64); rk1 = *(const u32x4*)(src + 7168); rk2 = *(const u32x4*)(src + 7168 + 64);
        rv = *(const u32x4*)(src + 8192 + 64 * eh);
    }
    int nxt;
#pragma unroll 1
    for (int n = 0; n < si.NC; ++n) {
        const int cn = dir ? si.NC - 1 - n : n, row0 = si.rowbase + 64 * cn;
        {
            const int i = si_i, s = si_s;
            float q1[8], q2[8], k1[8], k2[8];
            unpack8(rq1, q1); unpack8(rq2, q2); unpack8(rk1, k1); unpack8(rk2, k2);
            const float kes = __expf(lg * (float)(63 - sp(i, dir)));
            if (si.samp) {
#pragma unroll
                for (int j = 0; j < 8; ++j) { const float c = rcs[j >> 1][2 * (j & 1)], sn = rcs[j >> 1][2 * (j & 1) + 1];
                    const float a = q1[j] * c - q2[j] * sn, b = q2[j] * c + q1[j] * sn; q1[j] = a; q2[j] = b;
                    const float a2 = k1[j] * c - k2[j] * sn, b2 = k2[j] * c + k1[j] * sn; k1[j] = a2; k2[j] = b2; }
            }
#pragma unroll
            for (int j = 0; j < 8; ++j) { q1[j] *= QSCALE; q2[j] *= QSCALE; k1[j] *= kes; k2[j] *= kes; }
            *(LAS u32x4*)(q + i * PA + 8 * s) = pack8(q1); *(LAS u32x4*)(q + i * PA + 64 + 8 * s) = pack8(q2);
            *(LAS u32x4*)(ke + i * PA + 8 * s) = pack8(k1); *(LAS u32x4*)(ke + i * PA + 64 + 8 * s) = pack8(k2);
            *(LAS u32x4*)(vv + i * PB + 8 * s) = rv;
        }
        if (n + 1 < si.NC) {
            const int cn2 = dir ? si.NC - 2 - n : n + 1;
            { const f32x4* cs4 = (const f32x4*)(rope + (size_t)(((si_s < 4) ? cn2 : si_i) * 32 + rope_f0) * 2); rcs[0] = cs4[0]; rcs[1] = cs4[1]; rcs[2] = cs4[2]; rcs[3] = cs4[3]; }
            const bf16_t* src = PQ + (size_t)(si.rowbase + 64 * cn2 + si_i) * LDQ + h * 128 + 8 * si_s;
            rq1 = *(const u32x4*)(src + 6144); rq2 = *(const u32x4*)(src + 6144 + 64); rk1 = *(const u32x4*)(src + 7168); rk2 = *(const u32x4*)(src + 7168 + 64);
            rv = *(const u32x4*)(src + 8192 + 64 * eh);
        }
        if (n == si.NC - 1 && f.tid == 0) { unsigned zo = 0; asm volatile("" : "+v"(zo)); nxt = (int)__hip_atomic_fetch_add(qnext + zo, 1u, __ATOMIC_RELAXED, __HIP_MEMORY_SCOPE_AGENT); }
        __syncthreads();
#pragma unroll
        for (int t2 = 0; t2 < 2; ++t2) {
            const int tt = 2 * wid + t2, tm = tt >> 2, tn = tt & 3;
            f32x4 a = {0.f, 0.f, 0.f, 0.f};
#pragma unroll
            for (int ks = 0; ks < 4; ++ks) a = mfma16(rd_frag(ke, PA, 16 * tm, 32 * ks, lane), rd_frag(q, PA, 16 * tn, 32 * ks, lane), a);
            const int j0 = 16 * tm + 4 * (lane >> 4), i = 16 * tn + (lane & 15), pi = sp(i, dir);
            const float rsc = __expf(lg * (float)(pi - 63));
            f32x4 v;
#pragma unroll
            for (int r = 0; r < 4; ++r) v[r] = (sp(j0 + r, dir) <= pi) ? a[r] * rsc : 0.f;
            *(LAS u32x2*)(P + i * PB + j0) = pack4(v);
        }
        const int te = wid >> 1, ti0 = 2 * (wid & 1);
        f32x4 accO[2] = {{0.f, 0.f, 0.f, 0.f}, {0.f, 0.f, 0.f, 0.f}};
#pragma unroll
        for (int ks = 0; ks < 4; ++ks) {
            const bf16x8 a = rd_frag(ST, PA, 16 * te, 32 * ks, lane);
            accO[0] = mfma16(a, rd_frag(q, PA, 16 * ti0, 32 * ks, lane), accO[0]);
            accO[1] = mfma16(a, rd_frag(q, PA, 16 * ti0 + 16, 32 * ks, lane), accO[1]);
        }
        accO[0] *= __expf(lg * (float)(sp(16 * ti0 + (lane & 15), dir) + 1));
        accO[1] *= __expf(lg * (float)(sp(16 * ti0 + 16 + (lane & 15), dir) + 1));
        __syncthreads();
#pragma unroll
        for (int ks = 0; ks < 2; ++ks) {
            const bf16x8 a = tr_frag(vv, PB, 32 * ks, 16 * te, lane);
            accO[0] = mfma16(a, rd_frag(P, PB, 16 * ti0, 32 * ks, lane), accO[0]);
            accO[1] = mfma16(a, rd_frag(P, PB, 16 * ti0 + 16, 32 * ks, lane), accO[1]);
        }
#pragma unroll
        for (int t = 0; t < 2; ++t)
            *(u32x2*)(HS + (size_t)(row0 + 16 * (ti0 + t) + (lane & 15)) * 1024 + h * 128 + 64 * eh + 16 * te + 4 * (lane >> 4)) = pack4(accO[t]);
        {
            const bf16x8 a0 = tr_frag(ke, PA, 0, 16 * wid, lane), a1 = tr_frag(ke, PA, 32, 16 * wid, lane);
#pragma unroll
            for (int t = 0; t < 4; ++t) {
                accS[t] = mfma16(a0, tr_frag(vv, PB, 0, 16 * t, lane), accS[t] * cdec);
                accS[t] = mfma16(a1, tr_frag(vv, PB, 32, 16 * t, lane), accS[t]);
                *(LAS u32x2*)(ST + (16 * t + (lane & 15)) * PA + 16 * wid + 4 * (lane >> 4)) = pack4(accS[t]);
            }
        }
        __syncthreads();
    }
    if (!si.samp) state_store(accS, f.out + OUT_RS + sidx * 16384, eh, f);
    if (f.tid == 0) *(volatile LAS int*)(f.lds + LDS_BYTES - 128) = nxt;
}

__device__ __forceinline__ void mlstm_item(const Params& p, int l, int seq, int h, int dir, int eh, unsigned* qnext, const Frame& f) {
    LAS bf16_t* q = (LAS bf16_t*)(f.lds + SC_Q); LAS bf16_t* k = (LAS bf16_t*)(f.lds + SC_K); LAS bf16_t* kw = (LAS bf16_t*)(f.lds + SC_K2);
    LAS bf16_t* vv = (LAS bf16_t*)(f.lds + SC_V); LAS bf16_t* P = (LAS bf16_t*)(f.lds + SC_P); LAS bf16_t* CT = (LAS bf16_t*)(f.lds + SC_ST);
    LAS float* vec = (LAS float*)(f.lds + SC_VEC);
    LAS float* va = vec, *vr = vec + 64, *vwp = vec + 128, *vem = vec + 192, *vwt = vec + 256, *vqn = vec + 320, *vdd = vec + 384, *nvec = vec + 448, *scv = vec + 576;
    const bf16_t* PQ = (const bf16_t*)(f.ws + WS_PQ); const float* GT = (const float*)(f.ws + WS_GT);
    bf16_t* HS = (bf16_t*)(f.ws + WS_HS) + (size_t)(0 * 2 + dir) * MROWS * 1024;
    const SeqInfo si = seq_info(seq);
    const int tid = f.tid, lane = f.lane, wid = f.wid;
    const float fbias = p.in[I_FBIAS][(l * 2 + dir) * 8 + h];
    const size_t sidx = state_index(si.b, l, dir, h);
    f32x4 accC[4], accN;
    __syncthreads();
    state_load(accC, si.samp ? p.in[I_SC] + sidx * 16384 : nullptr, eh, CT, f);
    {
        const int d0 = 16 * wid + 4 * (lane >> 4);
#pragma unroll
        for (int r = 0; r < 4; ++r) accN[r] = si.samp ? p.in[I_SN][sidx * 128 + d0 + r] : 0.f;
        if ((lane & 15) == 0) {
#pragma unroll
            for (int r = 0; r < 4; ++r) nvec[d0 + r] = accN[r]; }
    }
    float m_prev = si.samp ? p.in[I_SM][sidx] : 0.f;
    const int si_i = tid >> 3, si_s = tid & 7;
    u32x4 rq1, rq2, rk1, rk2, rv; float rig = 0.f, rfp = 0.f;
    {
        const int cn = dir ? si.NC - 1 : 0, row0 = si.rowbase + 64 * cn;
        const bf16_t* src = PQ + (size_t)(row0 + si_i) * LDQ + h * 128 + 8 * si_s;
        rq1 = *(const u32x4*)(src); rq2 = *(const u32x4*)(src + 64); rk1 = *(const u32x4*)(src + 1024); rk2 = *(const u32x4*)(src + 1024 + 64);
        rv = *(const u32x4*)(src + 2048 + 64 * eh);
        if (wid == 0) { const size_t row = (size_t)(row0 + sp(lane, dir)); rig = GT[row * 64 + dir * 8 + h]; rfp = GT[row * 64 + 16 + dir * 8 + h]; }
    }
    bf16x8 ones;
#pragma unroll
    for (int j = 0; j < 8; ++j) ones[j] = (short)0x3F80;
    int nxt;
#pragma unroll 1
    for (int n = 0; n < si.NC; ++n) {
        const int cn = dir ? si.NC - 1 - n : n, row0 = si.rowbase + 64 * cn;
#pragma unroll 1
        for (int rep = 0; rep < ((PROBE_SEG == 4) ? 2 : 1); ++rep)
        if (wid == 0) {
            const int i = sp(lane, dir);
            const float ig = rig, fp = rfp + fbias;
            const float lf = fminf(fp, 0.f) - __logf(1.0f + __expf(-fabsf(fp)));
            const float b = wave_scan_add(lf, lane), a = ig - b, pm = wave_scan_max(a, lane);
            const float bL = __shfl(b, 63), pmL = __shfl(pm, 63);
            const float mx = fmaxf(m_prev, pm);
            va[i] = a; vr[i] = -mx; vwp[i] = __expf(m_prev - mx); vem[i] = __expf(-(b + mx));
            const float m_new = bL + fmaxf(m_prev, pmL);
            vwt[i] = __expf(bL + a - m_new);
            if (lane == 0) { scv[0] = __expf(bL + m_prev - m_new); scv[1] = m_new; }
        }
#pragma unroll 1
        for (int rep = 0; rep < ((PROBE_SEG == 3) ? 2 : 1); ++rep)
        {
            const int i = si_i, s = si_s;
            float k1[8], k2[8];
            unpack8(rk1, k1); unpack8(rk2, k2);
#pragma unroll
            for (int j = 0; j < 8; ++j) { k1[j] *= QSCALE; k2[j] *= QSCALE; }
            *(LAS u32x4*)(q + i * PA + 8 * s) = rq1; *(LAS u32x4*)(q + i * PA + 64 + 8 * s) = rq2;
            *(LAS u32x4*)(k + i * PA + 8 * s) = pack8(k1); *(LAS u32x4*)(k + i * PA + 64 + 8 * s) = pack8(k2);
            *(LAS u32x4*)(vv + i * PB + 8 * s) = rv;
        }
        if (n + 1 < si.NC) {
            const int cn2 = dir ? si.NC - 2 - n : n + 1, row2 = si.rowbase + 64 * cn2;
            const bf16_t* src = PQ + (size_t)(row2 + si_i) * LDQ + h * 128 + 8 * si_s;
            rq1 = *(const u32x4*)(src); rq2 = *(const u32x4*)(src + 64); rk1 = *(const u32x4*)(src + 1024); rk2 = *(const u32x4*)(src + 1024 + 64);
            rv = *(const u32x4*)(src + 2048 + 64 * eh);
            if (wid == 0) { const size_t row = (size_t)(row2 + sp(lane, dir)); rig = GT[row * 64 + dir * 8 + h]; rfp = GT[row * 64 + 16 + dir * 8 + h]; }
        }
        if (n == si.NC - 1 && f.tid == 0) { unsigned zo = 0; asm volatile("" : "+v"(zo)); nxt = (int)__hip_atomic_fetch_add(qnext + zo, 1u, __ATOMIC_RELAXED, __HIP_MEMORY_SCOPE_AGENT); }
        __syncthreads();
#pragma unroll 1
        for (int rep = 0; rep < ((PROBE_SEG == 1) ? 2 : 1); ++rep)
#pragma unroll
        for (int t2 = 0; t2 < 2; ++t2) {
            const int tt = 2 * wid + t2, tm = tt >> 2, tn = tt & 3;
            f32x4 a = {0.f, 0.f, 0.f, 0.f};
#pragma unroll
            for (int ks = 0; ks < 4; ++ks) a = mfma16(rd_frag(k, PA, 16 * tm, 32 * ks, lane), rd_frag(q, PA, 16 * tn, 32 * ks, lane), a);
            const int j0 = 16 * tm + 4 * (lane >> 4), i = 16 * tn + (lane & 15), pi = sp(i, dir);
            const float ri = vr[i];
            f32x4 v;
#pragma unroll
            for (int r = 0; r < 4; ++r) { const float e = a[r] * __expf(fminf(va[j0 + r] + ri, 0.f)); v[r] = (sp(j0 + r, dir) <= pi) ? e : 0.f; }
            *(LAS u32x2*)(P + i * PB + j0) = pack4(v);
        }
        const int te = wid >> 1, ti0 = 2 * (wid & 1);
        f32x4 accO[2] = {{0.f, 0.f, 0.f, 0.f}, {0.f, 0.f, 0.f, 0.f}};
#pragma unroll 1
        for (int rep = 0; rep < ((PROBE_SEG == 2) ? 2 : 1); ++rep) { accO[0] = (f32x4){0.f, 0.f, 0.f, 0.f}; accO[1] = accO[0]; asm volatile("" : "+v"(accO[0]), "+v"(accO[1]));
#pragma unroll
        for (int ks = 0; ks < 4; ++ks) {
            const bf16x8 a = rd_frag(CT, PA, 16 * te, 32 * ks, lane);
            accO[0] = mfma16(a, rd_frag(q, PA, 16 * ti0, 32 * ks, lane), accO[0]);
            accO[1] = mfma16(a, rd_frag(q, PA, 16 * ti0 + 16, 32 * ks, lane), accO[1]);
        }
        }
        accO[0] *= vwp[16 * ti0 + (lane & 15)];
        accO[1] *= vwp[16 * ti0 + 16 + (lane & 15)];
        {
            const int i = tid >> 3, s = tid & 7; float sum = 0.f;
            float x0[8], x1[8];
            unpack8(*(const LAS u32x4*)(q + i * PA + 16 * s), x0); unpack8(*(const LAS u32x4*)(q + i * PA + 16 * s + 8), x1);
#pragma unroll
            for (int c = 0; c < 8; ++c) sum += x0[c] * nvec[16 * s + c] + x1[c] * nvec[16 * s + 8 + c];
            sum += __shfl_xor(sum, 1); sum += __shfl_xor(sum, 2); sum += __shfl_xor(sum, 4);
            if (s == 0) vqn[i] = sum;
        }
        __syncthreads();
#pragma unroll
        for (int ks = 0; ks < 2; ++ks) {
            const bf16x8 a = tr_frag(vv, PB, 32 * ks, 16 * te, lane);
            accO[0] = mfma16(a, rd_frag(P, PB, 16 * ti0, 32 * ks, lane), accO[0]);
            accO[1] = mfma16(a, rd_frag(P, PB, 16 * ti0 + 16, 32 * ks, lane), accO[1]);
        }
        {
            const int i = tid >> 3, s = tid & 7; float x0[8];
            unpack8(*(const LAS u32x4*)(P + i * PB + 8 * s), x0);
            float sum = ((x0[0] + x0[1]) + (x0[2] + x0[3])) + ((x0[4] + x0[5]) + (x0[6] + x0[7]));
            sum += __shfl_xor(sum, 1); sum += __shfl_xor(sum, 2); sum += __shfl_xor(sum, 4);
            if (s == 0) { const float den = vwp[i] * vqn[i] + sum; vdd[i] = fmaxf(fabsf(den), vem[i]); }
        }
        const float ws = scv[0];
        {
            bf16x8 a0 = tr_frag(k, PA, 0, 16 * wid, lane), a1 = tr_frag(k, PA, 32, 16 * wid, lane);
            {
                const int j0 = 8 * (lane >> 4);
                const f32x4 wa = *(const LAS f32x4*)(vwt + j0), wb = *(const LAS f32x4*)(vwt + j0 + 4), wc2 = *(const LAS f32x4*)(vwt + 32 + j0), wd = *(const LAS f32x4*)(vwt + 32 + j0 + 4);
                u32x4 u0 = __builtin_bit_cast(u32x4, a0), u1 = __builtin_bit_cast(u32x4, a1);
                u0.x = cvt_pk_bf16(bflo(u0.x) * wa[0], bfhi(u0.x) * wa[1]); u0.y = cvt_pk_bf16(bflo(u0.y) * wa[2], bfhi(u0.y) * wa[3]);
                u0.z = cvt_pk_bf16(bflo(u0.z) * wb[0], bfhi(u0.z) * wb[1]); u0.w = cvt_pk_bf16(bflo(u0.w) * wb[2], bfhi(u0.w) * wb[3]);
                u1.x = cvt_pk_bf16(bflo(u1.x) * wc2[0], bfhi(u1.x) * wc2[1]); u1.y = cvt_pk_bf16(bflo(u1.y) * wc2[2], bfhi(u1.y) * wc2[3]);
                u1.z = cvt_pk_bf16(bflo(u1.z) * wd[0], bfhi(u1.z) * wd[1]); u1.w = cvt_pk_bf16(bflo(u1.w) * wd[2], bfhi(u1.w) * wd[3]);
                a0 = __builtin_bit_cast(bf16x8, u0); a1 = __builtin_bit_cast(bf16x8, u1);
            }
            accN = mfma16(a0, ones, accN * ws); accN = mfma16(a1, ones, accN);
#pragma unroll
            for (int t = 0; t < 4; ++t) {
                accC[t] = mfma16(a0, tr_frag(vv, PB, 0, 16 * t, lane), accC[t] * ws);
                accC[t] = mfma16(a1, tr_frag(vv, PB, 32, 16 * t, lane), accC[t]);
            }
        }
        m_prev = scv[1];
        __syncthreads();
#pragma unroll
        for (int t = 0; t < 2; ++t) {
            const int i = 16 * (ti0 + t) + (lane & 15);
            const float inv = 1.0f / vdd[i];
            *(u32x2*)(HS + (size_t)(row0 + i) * 1024 + h * 128 + 64 * eh + 16 * te + 4 * (lane >> 4)) = pack4(accO[t] * inv);
        }
#pragma unroll
        for (int t = 0; t < 4; ++t) *(LAS u32x2*)(CT + (16 * t + (lane & 15)) * PA + 16 * wid + 4 * (lane >> 4)) = pack4(accC[t]);
        if ((lane & 15) == 0) {
#pragma unroll
            for (int r = 0; r < 4; ++r) nvec[16 * wid + 4 * (lane >> 4) + r] = accN[r]; }
    }
    if (!si.samp) {
        state_store(accC, f.out + OUT_C + sidx * 16384, eh, f);
        if (eh == 0) {
            if ((lane & 15) == 0) {
#pragma unroll
                for (int r = 0; r < 4; ++r) f.out[OUT_N + sidx * 128 + 16 * wid + 4 * (lane >> 4) + r] = accN[r]; }
            if (tid == 0) f.out[OUT_M + sidx] = m_prev;
        }
    }
    if (f.tid == 0) *(volatile LAS int*)(f.lds + LDS_BYTES - 128) = nxt;
}

__device__ __forceinline__ void delta_item(const Params& p, int l, int seq, int h, int dir, int eh, unsigned* qnext, const Frame& f) {
    LAS bf16_t* q = (LAS bf16_t*)(f.lds + SC_Q); LAS bf16_t* Wk = (LAS bf16_t*)(f.lds + SC_K);
    LAS bf16_t* UT = (LAS bf16_t*)(f.lds + SC_V); LAS bf16_t* ST = (LAS bf16_t*)(f.lds + SC_ST);
    constexpr int SC_KE2 = 96768, SC_QK2 = 115200;
    LAS float* veg = (LAS float*)(f.lds + SC_VEC);
    const bf16_t* QN = (const bf16_t*)(f.ws + WS_QN); const bf16_t* KNg = (const bf16_t*)(f.ws + WS_KT); const bf16_t* U0T = (const bf16_t*)(f.ws + WS_U0T);
    const bf16_t* WKg = (const bf16_t*)(f.ws + WS_WK); const bf16_t* QKD = (const bf16_t*)(f.ws + WS_QKD); const float* GCH = (const float*)(f.ws + WS_GCH);
    bf16_t* HS = (bf16_t*)(f.ws + WS_HS) + (size_t)(1 * 2 + dir) * MROWS * 1024;
    const SeqInfo si = seq_info(seq);
    const int tid = f.tid, lane = f.lane, wid = f.wid;
    const size_t sidx = state_index(si.b, l, dir, h);
    f32x4 accS[4];
    __syncthreads();
    state_load(accS, si.samp ? p.in[I_SD] + sidx * 16384 : nullptr, eh, ST, f);
    const int si_i = tid >> 3, si_s = tid & 7;
    const int ti_u = wid >> 1, te_u0 = 2 * (wid & 1);
    u32x4 rq1, rq2, rw1, rw2, rk1, rk2, rqk; u32x2 ru0, ru1; float rG = 0.f, rGl = 0.f;
    {
        const int cn = dir ? si.NC - 1 : 0, row0 = si.rowbase + 64 * cn, chd = ((row0 >> 6) * 8 + h) * 2 + dir;
        const bf16_t* sq = QN + (size_t)(row0 + si_i) * 1024 + h * 128 + 16 * si_s; rq1 = *(const u32x4*)sq; rq2 = *(const u32x4*)(sq + 8);
        const bf16_t* sk = KNg + (size_t)(row0 + si_i) * 1024 + h * 128 + 16 * si_s; rk1 = *(const u32x4*)sk; rk2 = *(const u32x4*)(sk + 8);
        const bf16_t* sw = WKg + (size_t)chd * 8192 + si_i * 128 + 16 * si_s; rw1 = *(const u32x4*)sw; rw2 = *(const u32x4*)(sw + 8);
        rqk = *(const u32x4*)(QKD + (size_t)chd * 4096 + si_i * 64 + 8 * si_s);
        const bf16_t* su = U0T + (size_t)chd * 8192 + (size_t)(64 * eh + 16 * te_u0 + (lane & 15)) * 64 + 16 * ti_u + 4 * (lane >> 4);
        ru0 = *(const u32x2*)su; ru1 = *(const u32x2*)(su + 16 * 64);
        rG = GCH[(size_t)chd * 64 + si_i]; rGl = GCH[(size_t)chd * 64 + (dir ? 0 : 63)];
    }
    int nxt;
#pragma unroll 1
    for (int n = 0; n < si.NC; ++n) {
        const int cn = dir ? si.NC - 1 - n : n, row0 = si.rowbase + 64 * cn;
        const float Glast = rGl;
        const u32x2 cu0 = ru0, cu1 = ru1;
        LAS bf16_t* ke = (LAS bf16_t*)(f.lds + SC_K2); LAS bf16_t* QKd = (LAS bf16_t*)(f.lds + SC_P);
#pragma unroll 1
        for (int rep = 0; rep < ((PROBE_SEG == 6) ? 2 : 1); ++rep)
        {
            const int i = si_i, s = si_s;
            *(LAS u32x4*)(q + i * PA + 16 * s) = rq1; *(LAS u32x4*)(q + i * PA + 16 * s + 8) = rq2;
            *(LAS u32x4*)(Wk + i * PA + 16 * s) = rw1; *(LAS u32x4*)(Wk + i * PA + 16 * s + 8) = rw2;
            *(LAS u32x4*)(QKd + i * PB + 8 * s) = rqk;
            float x0[8], x1[8];
            unpack8(rk1, x0); unpack8(rk2, x1);
            const float ksc = __expf(Glast - rG);
#pragma unroll
            for (int j = 0; j < 8; ++j) { x0[j] *= ksc; x1[j] *= ksc; }
            *(LAS u32x4*)(ke + i * PA + 16 * s) = pack8(x0); *(LAS u32x4*)(ke + i * PA + 16 * s + 8) = pack8(x1);
            if (s == 0) veg[i] = __expf(rG);
        }
        if (n + 1 < si.NC) {
            const int cn2 = dir ? si.NC - 2 - n : n + 1, row2 = si.rowbase + 64 * cn2, chd = ((row2 >> 6) * 8 + h) * 2 + dir;
            const bf16_t* sq = QN + (size_t)(row2 + si_i) * 1024 + h * 128 + 16 * si_s; rq1 = *(const u32x4*)sq; rq2 = *(const u32x4*)(sq + 8);
            const bf16_t* sk = KNg + (size_t)(row2 + si_i) * 1024 + h * 128 + 16 * si_s; rk1 = *(const u32x4*)sk; rk2 = *(const u32x4*)(sk + 8);
            const bf16_t* sw = WKg + (size_t)chd * 8192 + si_i * 128 + 16 * si_s; rw1 = *(const u32x4*)sw; rw2 = *(const u32x4*)(sw + 8);
            rqk = *(const u32x4*)(QKD + (size_t)chd * 4096 + si_i * 64 + 8 * si_s);
            const bf16_t* su = U0T + (size_t)chd * 8192 + (size_t)(64 * eh + 16 * te_u0 + (lane & 15)) * 64 + 16 * ti_u + 4 * (lane >> 4);
            ru0 = *(const u32x2*)su; ru1 = *(const u32x2*)(su + 16 * 64);
            rG = GCH[(size_t)chd * 64 + si_i]; rGl = GCH[(size_t)chd * 64 + (dir ? 0 : 63)];
        }
        if (n == si.NC - 1 && f.tid == 0) { unsigned zo = 0; asm volatile("" : "+v"(zo)); nxt = (int)__hip_atomic_fetch_add(qnext + zo, 1u, __ATOMIC_RELAXED, __HIP_MEMORY_SCOPE_AGENT); }
        __syncthreads();
#pragma unroll 1
        for (int rep = 0; rep < ((PROBE_SEG == 5) ? 2 : 1); ++rep)
        {
            f32x4 a0 = {0.f, 0.f, 0.f, 0.f}, a1 = a0;
#pragma unroll
            for (int ks = 0; ks < 4; ++ks) {
                const bf16x8 a = rd_frag(Wk, PA, 16 * ti_u, 32 * ks, lane);
                a0 = mfma16(a, rd_frag(ST, PA, 16 * te_u0, 32 * ks, lane), a0);
                a1 = mfma16(a, rd_frag(ST, PA, 16 * te_u0 + 16, 32 * ks, lane), a1);
            }
            const int i0 = 16 * ti_u + 4 * (lane >> 4);
            f32x4 u; u[0] = bflo(cu0.x) - a0[0]; u[1] = bfhi(cu0.x) - a0[1]; u[2] = bflo(cu0.y) - a0[2]; u[3] = bfhi(cu0.y) - a0[3];
            *(LAS u32x2*)(UT + (16 * te_u0 + (lane & 15)) * PB + i0) = pack4(u);
            u[0] = bflo(cu1.x) - a1[0]; u[1] = bfhi(cu1.x) - a1[1]; u[2] = bflo(cu1.y) - a1[2]; u[3] = bfhi(cu1.y) - a1[3];
            *(LAS u32x2*)(UT + (16 * te_u0 + 16 + (lane & 15)) * PB + i0) = pack4(u);
        }
        const int te = wid >> 1, ti0 = 2 * (wid & 1);
        f32x4 accO[2] = {{0.f, 0.f, 0.f, 0.f}, {0.f, 0.f, 0.f, 0.f}};
#pragma unroll
        for (int ks = 0; ks < 4; ++ks) {
            const bf16x8 a = rd_frag(ST, PA, 16 * te, 32 * ks, lane);
            accO[0] = mfma16(a, rd_frag(q, PA, 16 * ti0, 32 * ks, lane), accO[0]);
            accO[1] = mfma16(a, rd_frag(q, PA, 16 * ti0 + 16, 32 * ks, lane), accO[1]);
        }
        accO[0] *= veg[16 * ti0 + (lane & 15)];
        accO[1] *= veg[16 * ti0 + 16 + (lane & 15)];
        __syncthreads();
#pragma unroll
        for (int ks = 0; ks < 2; ++ks) {
            const bf16x8 a = rd_frag(UT, PB, 16 * te, 32 * ks, lane);
            accO[0] = mfma16(a, rd_frag(QKd, PB, 16 * ti0, 32 * ks, lane), accO[0]);
            accO[1] = mfma16(a, rd_frag(QKd, PB, 16 * ti0 + 16, 32 * ks, lane), accO[1]);
        }
#pragma unroll
        for (int t = 0; t < 2; ++t)
            *(u32x2*)(HS + (size_t)(row0 + 16 * (ti0 + t) + (lane & 15)) * 1024 + h * 128 + 64 * eh + 16 * te + 4 * (lane >> 4)) = pack4(accO[t]);
        {
            const float cd = __expf(Glast);
            const bf16x8 a0 = tr_frag(ke, PA, 0, 16 * wid, lane), a1 = tr_frag(ke, PA, 32, 16 * wid, lane);
#pragma unroll
            for (int t = 0; t < 4; ++t) {
                accS[t] = mfma16(a0, rd_frag(UT, PB, 16 * t, 0, lane), accS[t] * cd);
                accS[t] = mfma16(a1, rd_frag(UT, PB, 16 * t, 32, lane), accS[t]);
                *(LAS u32x2*)(ST + (16 * t + (lane & 15)) * PA + 16 * wid + 4 * (lane >> 4)) = pack4(accS[t]);
            }
        }
        __syncthreads();
    }
    if (!si.samp) state_store(accS, f.out + OUT_DS + sidx * 16384, eh, f);
    if (f.tid == 0) *(volatile LAS int*)(f.lds + LDS_BYTES - 128) = nxt;
}

__device__ __forceinline__ int scan_dequeue(unsigned* q, const Frame& f) {
    volatile LAS int* slot = (volatile LAS int*)(f.lds + LDS_BYTES - 128);
    __syncthreads();
    if (f.tid == 0) *slot = (int)__hip_atomic_fetch_add(q, 1u, __ATOMIC_RELAXED, __HIP_MEMORY_SCOPE_AGENT);
    __syncthreads();
    return *slot;
}
__device__ __forceinline__ bool scan_decode(int g, int& seq, int& h, int& dir, int& eh) {
    if (g >= 576) return false;
    if (g < 64) { seq = 16 + (g >> 5); h = (g >> 2) & 7; dir = (g >> 1) & 1; eh = g & 1; return true; }
    const int idx = g - 64; seq = idx >> 5; h = (idx >> 2) & 7; dir = (idx >> 1) & 1; eh = idx & 1; return true;
}
__device__ __forceinline__ void phase_scan(const Params& p, int l, const Frame& f, int mask = 7) {
    unsigned* q = (unsigned*)(f.ws + WS_QUEUE) + (size_t)l * 3 * 64;
    const int start = (f.bid < 64 || f.bid >= 192) ? 0 : (f.bid < 128 ? 1 : 2);
    const bool stat = (f.G == 256) && (mask == 7);
    volatile LAS int* slot = (volatile LAS int*)(f.lds + LDS_BYTES - 128);
    int seq, h, dir, eh;
#pragma unroll 1
    for (int r = 0; r < 3; ++r) {
        const int X = (start + r) % 3;
        if (!((mask >> X) & 1)) continue;
        const int base = stat ? (X == 0 ? 128 : 64) : 0;
        int g = (stat && r == 0) ? (f.bid < 64 ? f.bid : (f.bid >= 192 ? f.bid - 128 : (f.bid & 63))) : scan_dequeue(q + 64 * X, f) + base;
#pragma unroll 1
        for (;;) {
            if (!scan_decode(g, seq, h, dir, eh)) break;
            Frame fi = f; { int t = f.tid; asm volatile("" : "+v"(t)); fi.tid = t; fi.lane = t & 63; }
            if (X == 0) mlstm_item(p, l, seq, h, dir, eh, q + 64 * X, fi);
            else if (X == 1) delta_item(p, l, seq, h, dir, eh, q + 64 * X, fi);
            else ret_item(p, l, seq, h, dir, eh, q + 64 * X, fi);
            __syncthreads();
            g = *slot + base;
        }
    }
}

template <class Epi> __device__ __forceinline__ void run_gemm(const bf16_t* A, const bf16_t* Bt, int N, int K, const Epi& E, const Frame& f) {
    pg8::Gemm g{A, Bt, MROWS, N, K};
    pg8::StaticOrder S; S.init(MROWS, N, f.G, f.bid, N > 8192 ? WGM_WIN : (N == 8192 ? WGM_UP : WGM_N2K));
    pg8::gemm_phase<Epi, pg8::StaticOrder, true, true>(f.lds, g, S, E);
}
__device__ __forceinline__ void phase_ffn_up(const Params& p, int l, int j, const Frame& f) {
    pg8::EpiSwiglu E{(bf16_t*)(f.ws + WS_HID), 4096, (const float*)(f.ws + WS_SS) + (size_t)(l * 3 + (j == 0 ? 0 : 2)) * MROWS,
                     (const float*)(f.ws + WS_SHW) + (size_t)l * SHW_LAYER + (j == 0 ? 0 : SHW_UP1)};
    run_gemm((const bf16_t*)(f.ws + (j == 0 ? WS_H : WS_XB3)), (const bf16_t*)(f.ws + wofs(l) + WS_W13T) + (size_t)j * 8192 * 2048, 8192, 2048, E, f);
}
template <int j> __device__ __forceinline__ void phase_ffn_down(const Params& p, int l, const Frame& f) {
    const float* ada_l = (const float*)(f.ws + WS_ADA) + (size_t)l * 3 * 18432;
    const bool lastl = (j == 1 && l == 1);
    const int nl = lastl ? 1 : ((j == 0) ? l : l + 1), nw = (j == 0) ? 1 : 0;
    const bool firstres = (j == 0 && l == 0);
    pg8::EpiResid<(j == 0 ? 2 : 8), true> E{f.out + OUT_Y, ada_l, firstres ? p.in[I_XP] : f.out + OUT_Y, firstres ? p.in[I_XS] - (size_t)4096 * 2048 : f.out + OUT_Y,
                    (bf16_t*)(f.ws + WS_H), p.in[I_NORMG] + (size_t)(nl * 3 + nw) * 2048,
                    (const float*)(f.ws + WS_ADA) + (size_t)nl * 3 * 18432 + (size_t)(3 * nw + 1) * 2048,
                    (float*)(f.ws + WS_SS) + (size_t)(lastl ? 6 : nl * 3 + nw) * MROWS, lastl ? 0 : 1};
    run_gemm((const bf16_t*)(f.ws + WS_HID), (const bf16_t*)(f.ws + wofs(l) + WS_W2T) + (size_t)j * 2048 * 4096, 2048, 4096, E, f);
    convert_fill(p, l, j == 0 ? 0 : 5, f);
}
__device__ __forceinline__ void phase_win(const Params& p, int l, const Frame& f) {
    pg8::EpiWin E{(bf16_t*)(f.ws + WS_PQ), (bf16_t*)(f.ws + WS_PG), (float*)(f.ws + WS_GT), (const float*)(f.ws + (l ? WS_BIASP1 : WS_BIASP)),
                  (const float*)(f.ws + WS_SS) + (size_t)(l * 3 + 1) * MROWS, (const float*)(f.ws + WS_SHW) + (size_t)l * SHW_LAYER + SHW_WIN};
    run_gemm((const bf16_t*)(f.ws + WS_H), (const bf16_t*)(f.ws + wofs(l) + WS_WINT), NINP, 2048, E, f);
    convert_fill(p, l, 6, f);
}
__device__ __forceinline__ void phase_br(const Params& p, int l, const Frame& f) {
#pragma unroll 1
    for (int seg = 0; seg < 3; ++seg) {
        pg8::EpiBr E{(const bf16_t*)(f.ws + WS_PG), (float*)(f.ws + WS_TMP), (bf16_t*)(f.ws + WS_H), seg};
        run_gemm((const bf16_t*)(f.ws + WS_YS) + (size_t)seg * MROWS * 1024, (const bf16_t*)(f.ws + wofs(l) + WS_WBRT) + (size_t)seg * 2048 * 1024, 2048, 1024, E, f);
        convert_fill(p, l, 1 + seg, f);
        asm volatile("s_waitcnt vmcnt(0)" ::: "memory");
        __syncthreads();
    }
}
__device__ __forceinline__ void phase_wout(const Params& p, int l, const Frame& f) {
    const float* ada_l = (const float*)(f.ws + WS_ADA) + (size_t)l * 3 * 18432;
    pg8::EpiResid<5, false> E{f.out + OUT_Y, ada_l, f.out + OUT_Y, f.out + OUT_Y, (bf16_t*)(f.ws + WS_XB3), p.in[I_NORMG] + (size_t)(l * 3 + 2) * 2048, ada_l + (size_t)7 * 2048, (float*)(f.ws + WS_SS) + (size_t)(l * 3 + 2) * MROWS, 1};
    run_gemm((const bf16_t*)(f.ws + WS_H), (const bf16_t*)(f.ws + wofs(l) + WS_WOUTT), 2048, 2048, E, f);
    convert_fill(p, l, 4, f);
}

constexpr int N_PHASES = 14;
template <int PH> __device__ __forceinline__ void do_phase(const Params& p, int l, const Frame& f) {
    if constexpr (PH == 0) { phase_rope(p, f); if (f.G == 256) phase_ada(p, 0, f.bid, f.G, f, 0, 256); else { phase_ada(p, 0, f.bid, f.G, f); phase_ada(p, 1, f.bid, f.G, f); } }
    else if constexpr (PH == 1) { phase_convert(p, l, f); if (l == 0) { phase_copy_norm(p, f); if (f.G == 256) phase_ada(p, 0, f.bid, f.G, f, 256, 9 * 128); } }
    else if constexpr (PH == 2) phase_ffn_up(p, l, 0, f);
    else if constexpr (PH == 3) phase_ffn_down<0>(p, l, f);
    else if constexpr (PH == 5) phase_win(p, l, f);
    else if constexpr (PH == 6) phase_delta_prep(p, l, f);
    else if constexpr (PH == 7) phase_scan(p, l, f);
    else if constexpr (PH == 107) phase_scan(p, l, f, PROBE_SCAN_MASK);
    else if constexpr (PH == 8) phase_merge(p, l, f);
    else if constexpr (PH == 9) phase_br(p, l, f);
    else if constexpr (PH == 10) phase_wout(p, l, f);
    else if constexpr (PH == 12) phase_ffn_up(p, l, 1, f);
    else if constexpr (PH == 13) phase_ffn_down<1>(p, l, f);
    else if constexpr (PH == 14) phase_final_norm(p, f);
}
__device__ __forceinline__ Frame make_frame(unsigned char* lds_generic, const Params& p) {
    int t = threadIdx.x; asm volatile("" : "+v"(t));
    int b = blockIdx.x; asm volatile("" : "+s"(b));
    Frame f; f.tid = t; f.wid = __builtin_amdgcn_readfirstlane(t >> 6); f.lane = t & 63; f.bid = b; f.G = gridDim.x;
    size_t z = 0; asm volatile("" : "+s"(z));
    f.ws = p.ws + z; f.out = p.out + z;
    f.lds = (LAS unsigned char*)lds_generic; return f;
}

#if ONE_LAUNCH
__global__ void __launch_bounds__(512, 2) mega_fwd(Params p, int step_first, int step_last) {
    extern __shared__ __attribute__((aligned(16))) unsigned char lds_raw[];
    volatile LAS unsigned* xbw = (volatile LAS unsigned*)((LAS unsigned char*)lds_raw + LDS_WORK);
    if (threadIdx.x < 4) xbw[threadIdx.x] = 0u;
    __syncthreads();
    XcdBarrier bar = xcd_barrier_post((unsigned*)(p.ws + WS_CTL), xbw);
#ifndef PROBE_DUP
#define PROBE_DUP 0
#endif
#define MK_PHASE(k) if (step >= step_first && step < step_last) { { const Frame f = make_frame(lds_raw, p); do_phase<k>(p, l, f); } xcd_barrier(bar); if (PROBE_BAR) xcd_barrier(bar); } ++step; \
    if constexpr ((PROBE_DUP >> k) & 1) { { const Frame f = make_frame(lds_raw, p); do_phase<(k == 7 ? 107 : k)>(p, l, f); } xcd_barrier(bar); }
    int step = 0;
#pragma unroll 1
    for (int l = 0; l < 2; ++l) {
        if (l == 0) { MK_PHASE(0) }
        if (l == 0 || gridDim.x != 256) { MK_PHASE(1) }
        MK_PHASE(2) MK_PHASE(3) MK_PHASE(5) MK_PHASE(6) MK_PHASE(7) MK_PHASE(8) MK_PHASE(9) MK_PHASE(10) MK_PHASE(12) MK_PHASE(13)
    }
    if (step_last < 1000) return;
    const Frame f = make_frame(lds_raw, p);
    do_phase<14>(p, 0, f);
}
#else
template <int PH> __global__ void __launch_bounds__(512, 2) phase_kernel(Params p, int l) {
    extern __shared__ __attribute__((aligned(16))) unsigned char lds_raw[];
    const Frame f = make_frame(lds_raw, p);
    do_phase<PH>(p, l, f);
}
template <int PH> static void launch_phase(const Params& p, int l, int grid, hipStream_t stream) {
    static bool attr_done = false;
    if (!attr_done) { (void)hipFuncSetAttribute((const void*)phase_kernel<PH>, hipFuncAttributeMaxDynamicSharedMemorySize, LDS_BYTES); attr_done = true; }
    hipLaunchKernelGGL(phase_kernel<PH>, dim3(grid), dim3(NTHREADS), LDS_BYTES, stream, p, l);
}
#endif

#if !ONE_LAUNCH
__global__ void dump_kernel(Params p, size_t off_bytes, int nslices) {
    const bf16_t* b = (const bf16_t*)(p.ws + off_bytes);
    const size_t n = 12582912;
    for (size_t i = (size_t)blockIdx.x * blockDim.x + threadIdx.x; i < 2 * n; i += (size_t)gridDim.x * blockDim.x) {
        float v = 1.0f;
        if (i < n) { v = 0.f; for (int k = 0; k < nslices; ++k) v += (float)(k + 1) * bflo((unsigned)b[(size_t)k * n + i]); }
        p.out[i] = v;
    }
}
#endif
extern "C" void kernel_launch(void* const* d_in, const int* in_sizes, int n_in, void* d_out, int out_size, void* d_ws, size_t ws_size, hipStream_t stream) {
    if (n_in != N_INPUTS || (size_t)out_size != OUT_TOTAL || ws_size < WS_END) {
        fprintf(stderr, "kernel_launch: unexpected sizes: n_in %d out %d ws %zu (need %zu); nothing launched\n", n_in, out_size, ws_size, (size_t)WS_END); return; }
    Params p{};
    for (int i = 0; i < N_INPUTS; ++i) p.in[i] = (const float*)d_in[i];
    p.out = (float*)d_out; p.ws = (unsigned char*)d_ws;
    if (hipMemsetAsync((char*)d_ws + WS_CTL, 0, CTL_BYTES, stream) != hipSuccess) { fprintf(stderr, "kernel_launch: memset failed\n"); return; }
    static int grid = 0;
    if (!grid) {
        int dev = 0, cus = 0;
        if (hipGetDevice(&dev) != hipSuccess || hipDeviceGetAttribute(&cus, hipDeviceAttributeMultiprocessorCount, dev) != hipSuccess || cus <= 0) cus = 256;
        grid = cus;
#if ONE_LAUNCH
        if (hipFuncSetAttribute((const void*)mega_fwd, hipFuncAttributeMaxDynamicSharedMemorySize, LDS_BYTES) != hipSuccess) fprintf(stderr, "kernel_launch: hipFuncSetAttribute failed\n");
        int per_cu = 0;
        if (hipOccupancyMaxActiveBlocksPerMultiprocessor(&per_cu, (const void*)mega_fwd, NTHREADS, LDS_BYTES) != hipSuccess || per_cu < 1)
            fprintf(stderr, "kernel_launch: occupancy query reports %d workgroups per CU\n", per_cu);
#endif
    }
#if ONE_LAUNCH
#ifndef SPLIT_AT
    hipLaunchKernelGGL(mega_fwd, dim3(grid), dim3(NTHREADS), LDS_BYTES, stream, p, 0, 1000);
#else
    hipLaunchKernelGGL(mega_fwd, dim3(grid), dim3(NTHREADS), LDS_BYTES, stream, p, 0, (int)(SPLIT_AT));
    if (hipMemsetAsync((char*)d_ws + WS_CTL, 0, 16384, stream) != hipSuccess) return;
    hipLaunchKernelGGL(mega_fwd, dim3(grid), dim3(NTHREADS), LDS_BYTES, stream, p, (int)(SPLIT_AT), 1000);
#endif
#else
#ifndef STOP_AT
#define STOP_AT 1000
#endif
    int step = 0;
#define LP(k) if (step++ < STOP_AT) launch_phase<k>(p, l, grid, stream);
    for (int l = 0; l < 2; ++l) { if (l == 0) { LP(0) } LP(1) LP(2) LP(3) LP(5) LP(6) LP(7) LP(8) LP(9) LP(10) LP(12) LP(13) }
#ifdef DUMP_OFF
    hipLaunchKernelGGL(dump_kernel, dim3(2048), dim3(256), 0, stream, p, (size_t)(DUMP_OFF), (int)(DUMP_N));
#endif
    if (STOP_AT >= 1000)
    launch_phase<14>(p, 0, grid, stream);
#endif
}
```
